# Optimizing an MI355X kernel written in HIP

```python
import math
import jax, jax.numpy as jnp
from jax import lax
import numpy as np

D_MODEL = 1024
BATCH = 8
SEQ = 4096
DEPTH = 2

GRID_W = 64
CTX_LEN = 256
N_MOD = 6
NORM_EPS = 1e-6
SHORT_CONV = 3

RW_HEADS = 6
RW_HEAD_DIM = 64
RW_WIDTH = RW_HEADS * RW_HEAD_DIM
RW_DECAY_RANK = 64
RW_A_RANK = 64
RW_GATE_RANK = 128
RW_DECAY_SCALE = 0.6065306597
RW_GN_EPS = 64e-5
L2_EPS = 1e-12

MLA_HEADS = 6
MLA_Q_RANK = 256
MLA_KV_RANK = 128
MLA_NOPE_DIM = 64
MLA_ROPE_DIM = 32
MLA_V_DIM = 64
MLA_QK_DIM = MLA_NOPE_DIM + MLA_ROPE_DIM
MLA_WIDTH = MLA_HEADS * MLA_V_DIM
AXIS_ROPE_DIM = MLA_ROPE_DIM // 2
ROPE_THETA = 10000.0
Q_BLOCK = 128

HY_WIDTH = 256
HY_GROUPS = 4
HY_ORDER = 2
HY_POS_BANDS = 16
HY_POS_DIM = 1 + 2 * HY_POS_BANDS
HY_FILTER_HIDDEN = 64
HY_SHORT_DECAY_PCT = 0.3
HY_LONG_DECAY_PCT = 1.5
HY_DECAY_TARGET = 1e-2

PEER_HEADS = 8
PEER_N_KEYS = 128
PEER_N_EXPERTS = PEER_N_KEYS * PEER_N_KEYS
PEER_TOPK = 16
PEER_QUERY_DIM = 256
PEER_HALF = PEER_QUERY_DIM // 2
PEER_CHUNK = 128

RW_PROJ = 3 * RW_WIDTH + RW_DECAY_RANK + RW_A_RANK + RW_GATE_RANK
MLA_PROJ = MLA_Q_RANK + MLA_KV_RANK + MLA_ROPE_DIM
HY_PROJ = (HY_ORDER + 1) * HY_WIDTH
IN_PROJ = RW_PROJ + MLA_PROJ + HY_PROJ
MIX_WIDTH = RW_WIDTH + MLA_WIDTH + HY_WIDTH

kernel_name = 'hybrid_rwkv7_mla_hyena_peer_diffusion'


def rms_norm(x, gain):
    xf = x.astype(jnp.float32)
    y = xf * lax.rsqrt(jnp.mean(xf * xf, axis=-1, keepdims=True) + NORM_EPS)
    return (y * gain.astype(jnp.float32)).astype(x.dtype)


def short_conv(x, w):
    xp = jnp.pad(x, ((0, 0), (1, 1), (0, 0)))
    return xp[:, :-2] * w[0] + xp[:, 1:-1] * w[1] + xp[:, 2:] * w[2]


def _heads(t):
    return t.reshape(t.shape[:-1] + (RW_HEADS, RW_HEAD_DIM))


def rwkv7_prepare(p, conv_w, decay_up, decay0, a_up, a0, gate_up, k_k, k_a):
    z = short_conv(p, conv_w)
    o1, o2, o3 = RW_WIDTH, 2 * RW_WIDTH, 3 * RW_WIDTH
    o4 = o3 + RW_DECAY_RANK
    o5 = o4 + RW_A_RANK
    r, k, v = z[..., :o1], z[..., o1:o2], z[..., o2:o3]
    d_lo, a_lo, g_lo = z[..., o3:o4], z[..., o4:o5], z[..., o5:]
    decay = jnp.exp(-RW_DECAY_SCALE * jax.nn.sigmoid(
        decay0[:, None, None, :] + jnp.einsum('blr,nrc->nblc', jnp.tanh(d_lo), decay_up)))
    a = jax.nn.sigmoid(a0[:, None, None, :] + jnp.einsum('blr,nrc->nblc', a_lo, a_up))
    g = jnp.einsum('blr,rc->blc', jax.nn.sigmoid(g_lo), gate_up)
    kk = _heads(k * k_k).astype(jnp.float32)
    kk = kk * lax.rsqrt(jnp.sum(kk * kk, axis=-1, keepdims=True) + L2_EPS)
    k_rep = _heads(k)[None] * (1.0 + (_heads(a) - 1.0) * _heads(k_a))
    return _heads(r), _heads(k), _heads(v), _heads(decay), _heads(a), kk, k_rep, g


def rwkv7_scan(state0, r, decay, kk, a, k_rep, v, reverse):
    def step(S, inp):
        r_t, w_t, kk_t, a_t, k_t, v_t = inp
        S = (S * w_t[:, :, None, :]
             - jnp.einsum('bhvk,bhk->bhv', S, kk_t)[..., None] * (kk_t * a_t)[:, :, None, :]
             + v_t[..., None] * k_t[:, :, None, :])
        return S, jnp.einsum('bhvk,bhk->bhv', S, r_t)
    seq = tuple(jnp.moveaxis(t.astype(jnp.float32), 1, 0) for t in (r, decay, kk, a, k_rep, v))
    s_fin, y = lax.scan(step, state0, seq, reverse=reverse)
    return s_fin, jnp.moveaxis(y, 0, 1)


def rwkv7_readout(y, r, k, v, g, r_k, gn_g, gn_b):
    B, L = y.shape[:2]
    mu = jnp.mean(y, axis=-1, keepdims=True)
    var = jnp.mean(jnp.square(y - mu), axis=-1, keepdims=True)
    yn = ((y - mu) * lax.rsqrt(var + RW_GN_EPS)).reshape(B, L, RW_WIDTH) * gn_g + gn_b
    bonus = jnp.sum(r * k * r_k.reshape(RW_HEADS, RW_HEAD_DIM), axis=-1, keepdims=True) * v
    return ((yn + bonus.reshape(B, L, RW_WIDTH)) * g).astype(g.dtype)


def rwkv7_mixer(p_lat, p_ctx, conv_w, decay_up, decay0, a_up, a0, gate_up, k_k, k_a, r_k, gn_g, gn_b, need_ctx):
    prm = (conv_w, decay_up, decay0, a_up, a0, gate_up, k_k, k_a)
    lr, lk, lv, ldec, la, lkk, lkr, lg = rwkv7_prepare(p_lat, *prm)
    cr, ck, cv, cdec, ca, ckk, ckr, cg = rwkv7_prepare(p_ctx, *prm)
    B = p_lat.shape[0]
    ys_l, ys_c = [], []
    for d, rev in enumerate((False, True)):
        s0 = jnp.zeros((B, RW_HEADS, RW_HEAD_DIM, RW_HEAD_DIM), jnp.float32)
        s_ctx, yc = rwkv7_scan(s0, cr, cdec[d], ckk, ca[d], ckr[d], cv, rev)
        _, yl = rwkv7_scan(s_ctx, lr, ldec[d], lkk, la[d], lkr[d], lv, rev)
        ys_l.append(yl)
        ys_c.append(yc)
    out_l = rwkv7_readout(ys_l[0] + ys_l[1], lr, lk, lv, lg, r_k, gn_g, gn_b)
    out_c = rwkv7_readout(ys_c[0] + ys_c[1], cr, ck, cv, cg, r_k, gn_g, gn_b) if need_ctx else None
    return out_l, out_c


def axial_rope_tables(L):
    rows = L // GRID_W
    row, col = jnp.meshgrid(jnp.arange(rows), jnp.arange(GRID_W), indexing='ij')
    inv = ROPE_THETA ** (-jnp.arange(0, AXIS_ROPE_DIM, 2, dtype=jnp.float32) / AXIS_ROPE_DIM)
    pos = jnp.stack([row.reshape(-1), col.reshape(-1)], axis=-1).astype(jnp.float32)
    ang = pos[:, :, None] * inv[None, None, :]
    return jnp.cos(ang), jnp.sin(ang)


def apply_axial_rope(x, rope):
    cos, sin = rope
    B, L, H, _ = x.shape
    xa = x.reshape(B, L, H, 2, AXIS_ROPE_DIM).astype(jnp.float32)
    half = AXIS_ROPE_DIM // 2
    x1, x2 = xa[..., :half], xa[..., half:]
    cs, sn = cos[None, :, None], sin[None, :, None]
    out = jnp.concatenate([x1 * cs - x2 * sn, x2 * cs + x1 * sn], axis=-1)
    return out.reshape(B, L, H, MLA_ROPE_DIM).astype(x.dtype)


def mla_qkv(p, rope, q_norm, w_uq, kv_norm, w_ukv, q_gain, k_gain):
    B, L, _ = p.shape
    c_q = p[..., :MLA_Q_RANK]
    c_kv = p[..., MLA_Q_RANK:MLA_Q_RANK + MLA_KV_RANK]
    k_rope = p[..., MLA_Q_RANK + MLA_KV_RANK:]
    q = (rms_norm(c_q, q_norm) @ w_uq).reshape(B, L, MLA_HEADS, MLA_QK_DIM)
    kv = (rms_norm(c_kv, kv_norm) @ w_ukv).reshape(B, L, MLA_HEADS, MLA_NOPE_DIM + MLA_V_DIM)
    k = jnp.concatenate([kv[..., :MLA_NOPE_DIM],
                         jnp.broadcast_to(k_rope[:, :, None, :], (B, L, MLA_HEADS, MLA_ROPE_DIM))], axis=-1)
    v = kv[..., MLA_NOPE_DIM:]
    q = rms_norm(q, q_gain)
    k = rms_norm(k, k_gain)
    if rope is not None:
        q = jnp.concatenate([q[..., :MLA_NOPE_DIM], apply_axial_rope(q[..., MLA_NOPE_DIM:], rope)], axis=-1)
        k = jnp.concatenate([k[..., :MLA_NOPE_DIM], apply_axial_rope(k[..., MLA_NOPE_DIM:], rope)], axis=-1)
    return q, k, v


def softmax_attend(q, k, v):
    s = jnp.einsum('bqhd,bkhd->bhqk', q, k, preferred_element_type=jnp.float32) * (MLA_QK_DIM ** -0.5)
    pr = jax.nn.softmax(s, axis=-1)
    return jnp.einsum('bhqk,bkhd->bqhd', pr.astype(v.dtype), v)


def mla_mixer(p_lat, p_ctx, rope, q_norm, w_uq, kv_norm, w_ukv, q_gain, k_gain, need_ctx):
    prm = (q_norm, w_uq, kv_norm, w_ukv, q_gain, k_gain)
    q_l, k_l, v_l = mla_qkv(p_lat, rope, *prm)
    q_c, k_c, v_c = mla_qkv(p_ctx, None, *prm)
    k_all = jnp.concatenate([k_l, k_c], axis=1)
    v_all = jnp.concatenate([v_l, v_c], axis=1)
    B, L = p_lat.shape[:2]
    q_blocks = jnp.moveaxis(q_l.reshape(B, L // Q_BLOCK, Q_BLOCK, MLA_HEADS, MLA_QK_DIM), 1, 0)
    y_l = lax.map(lambda qb: softmax_attend(qb, k_all, v_all), q_blocks)
    y_l = jnp.moveaxis(y_l, 0, 1).reshape(B, L, MLA_WIDTH)
    y_c = softmax_attend(q_c, k_c, v_c).reshape(B, p_ctx.shape[1], MLA_WIDTH) if need_ctx else None
    return y_l, y_c


def hyena_filters(L, w1, b1, freq1, w2, b2, freq2, w3, b3):
    tn = jnp.arange(L, dtype=jnp.float32) / L
    bands = jnp.arange(1, HY_POS_BANDS + 1, dtype=jnp.float32)
    ang = 2.0 * math.pi * tn[:, None] * bands[None, :]
    z = jnp.concatenate([tn[:, None], jnp.cos(ang), jnp.sin(ang)], axis=-1)
    h = jnp.sin(freq1 * (z @ w1 + b1))
    h = jnp.sin(freq2 * (h @ w2 + b2))
    h = (h @ w3 + b3).reshape(L, HY_ORDER, 2, HY_WIDTH)
    rates = jnp.abs(jnp.linspace(math.log(HY_DECAY_TARGET) / HY_LONG_DECAY_PCT,
                                 math.log(HY_DECAY_TARGET) / HY_SHORT_DECAY_PCT, HY_WIDTH))
    h = h * jnp.exp(-tn[:, None] * rates[None, :])[:, None, None, :]
    zero = jnp.zeros((1, HY_ORDER, HY_WIDTH), h.dtype)
    h_full = jnp.concatenate([h[:, :, 0], zero, h[:0:-1, :, 1]], axis=0)
    return h_full * lax.rsqrt(jnp.sum(jnp.square(h_full), axis=0, keepdims=True))


def fft_long_conv(u, h_full, bias):
    L = u.shape[1]
    uf = jnp.fft.rfft(u.astype(jnp.float32), n=2 * L, axis=1)
    hf = jnp.fft.rfft(h_full, n=2 * L, axis=0)
    y = jnp.fft.irfft(uf * hf[None], n=2 * L, axis=1)[:, :L]
    return (y + u.astype(jnp.float32) * bias.astype(jnp.float32)).astype(u.dtype)


def hyena_mixer(p, conv_w, w1, b1, freq1, w2, b2, freq2, w3, b3, bias):
    L = p.shape[1]
    z = short_conv(p, conv_w)
    gates = (z[..., :HY_WIDTH], z[..., HY_WIDTH:2 * HY_WIDTH])
    y = z[..., 2 * HY_WIDTH:]
    h_full = hyena_filters(L, w1, b1, freq1, w2, b2, freq2, w3, b3)
    for o in range(HY_ORDER):
        y = gates[o] * fft_long_conv(y, h_full[:, o], bias[o])
    return y


def peer_ffn(h, w_q, sub_keys, exp_u, exp_v):
    B, L, D = h.shape
    chunks = h.reshape(B * L // PEER_CHUNK, PEER_CHUNK, D)

    def retrieve(xc):
        q = (xc @ w_q).reshape(PEER_CHUNK, PEER_HEADS, 2, PEER_HALF)
        s = jnp.einsum('thpd,hpnd->thpn', q, sub_keys, preferred_element_type=jnp.float32)
        sv, si = lax.top_k(s, PEER_TOPK)
        cand_s = (sv[:, :, 0, :, None] + sv[:, :, 1, None, :]).reshape(PEER_CHUNK, PEER_HEADS, PEER_TOPK * PEER_TOPK)
        cand_i = (si[:, :, 0, :, None] * PEER_N_KEYS + si[:, :, 1, None, :]).reshape(PEER_CHUNK, PEER_HEADS, PEER_TOPK * PEER_TOPK)
        top_s, top_j = lax.top_k(cand_s, PEER_TOPK)
        e_idx = jnp.take_along_axis(cand_i, top_j, axis=-1)
        gate = jax.nn.softmax(top_s, axis=-1)
        act = jax.nn.gelu(jnp.einsum('thkd,td->thk', exp_u[e_idx], xc).astype(jnp.float32), approximate=False)
        return jnp.einsum('thk,thkd->td', (gate * act).astype(xc.dtype), exp_v[e_idx])

    return lax.map(retrieve, chunks).reshape(B, L, D)


def setup_inputs(seed: int = 0) -> dict:
    key = jax.random.key(seed)
    keys = iter(jax.random.split(key, 64))

    def nrm(shape, scale):
        return scale * jax.random.normal(next(keys), shape, jnp.float32)

    def gain(shape):
        return 1.0 + nrm(shape, 0.02)

    centre = jnp.array([0.0, 1.0, 0.0], jnp.float32)[None, :, None]
    D = D_MODEL
    HF = HY_FILTER_HIDDEN
    return {
        'x': nrm((BATCH, SEQ, D), 1.0),
        'c': nrm((BATCH, D), 1.0),
        'ctx': nrm((BATCH, CTX_LEN, D), 1.0),
        'c_ctx': nrm((D,), 1.0),
        'mod_w': nrm((DEPTH, D, N_MOD * D), 0.5 * D ** -0.5),
        'mod_b': nrm((DEPTH, N_MOD * D), 0.02),
        'mix_norm': gain((DEPTH, D)),
        'w_in': nrm((DEPTH, D, IN_PROJ), D ** -0.5),
        'w_out': nrm((DEPTH, MIX_WIDTH, D), MIX_WIDTH ** -0.5),
        'rw_conv': centre + nrm((DEPTH, SHORT_CONV, RW_PROJ), 0.2),
        'rw_decay_up': nrm((DEPTH, 2, RW_DECAY_RANK, RW_WIDTH), 0.1),
        'rw_decay0': nrm((DEPTH, 2, RW_WIDTH), 0.5),
        'rw_a_up': nrm((DEPTH, 2, RW_A_RANK, RW_WIDTH), 0.5 * RW_A_RANK ** -0.5),
        'rw_a0': nrm((DEPTH, 2, RW_WIDTH), 0.5),
        'rw_gate_up': nrm((DEPTH, RW_GATE_RANK, RW_WIDTH), RW_GATE_RANK ** -0.5),
        'rw_k_k': 1.0 + nrm((DEPTH, RW_WIDTH), 0.1),
        'rw_k_a': 1.0 + nrm((DEPTH, RW_WIDTH), 0.1),
        'rw_r_k': nrm((DEPTH, RW_WIDTH), 0.1),
        'rw_gn_g': gain((DEPTH, RW_WIDTH)),
        'rw_gn_b': nrm((DEPTH, RW_WIDTH), 0.02),
        'mla_q_norm': gain((DEPTH, MLA_Q_RANK)),
        'mla_w_uq': nrm((DEPTH, MLA_Q_RANK, MLA_HEADS * MLA_QK_DIM), MLA_Q_RANK ** -0.5),
        'mla_kv_norm': gain((DEPTH, MLA_KV_RANK)),
        'mla_w_ukv': nrm((DEPTH, MLA_KV_RANK, MLA_HEADS * (MLA_NOPE_DIM + MLA_V_DIM)), MLA_KV_RANK ** -0.5),
        'mla_q_gain': gain((DEPTH, MLA_QK_DIM)),
        'mla_k_gain': gain((DEPTH, MLA_QK_DIM)),
        'hy_conv': centre + nrm((DEPTH, SHORT_CONV, HY_PROJ), 0.2),
        'hy_w1': nrm((DEPTH, HY_POS_DIM, HF), 1.0),
        'hy_b1': nrm((DEPTH, HF), 0.1),
        'hy_freq1': 1.0 + nrm((DEPTH, HF), 0.1),
        'hy_w2': nrm((DEPTH, HF, HF), HF ** -0.5),
        'hy_b2': nrm((DEPTH, HF), 0.1),
        'hy_freq2': 1.0 + nrm((DEPTH, HF), 0.1),
        'hy_w3': nrm((DEPTH, HF, HY_ORDER * 2 * HY_WIDTH), HF ** -0.5),
        'hy_b3': nrm((DEPTH, HY_ORDER * 2 * HY_WIDTH), 0.02),
        'hy_bias': nrm((DEPTH, HY_ORDER, HY_WIDTH), 0.1),
        'ffn_norm': gain((DEPTH, D)),
        'peer_wq': nrm((DEPTH, D, PEER_HEADS * PEER_QUERY_DIM), D ** -0.5),
        'peer_keys': nrm((DEPTH, PEER_HEADS, 2, PEER_N_KEYS, PEER_HALF), PEER_HALF ** -0.5),
        'peer_u': nrm((DEPTH, PEER_N_EXPERTS, D), D ** -0.5),
        'peer_v': nrm((DEPTH, PEER_N_EXPERTS, D), 0.5),
    }


def reference(x, c, ctx, c_ctx, mod_w, mod_b, mix_norm, w_in, w_out,
              rw_conv, rw_decay_up, rw_decay0, rw_a_up, rw_a0, rw_gate_up, rw_k_k, rw_k_a, rw_r_k, rw_gn_g, rw_gn_b,
              mla_q_norm, mla_w_uq, mla_kv_norm, mla_w_ukv, mla_q_gain, mla_k_gain,
              hy_conv, hy_w1, hy_b1, hy_freq1, hy_w2, hy_b2, hy_freq2, hy_w3, hy_b3, hy_bias,
              ffn_norm, peer_wq, peer_keys, peer_u, peer_v):
    L = x.shape[1]
    rope = axial_rope_tables(L)
    s_rw, s_mla = RW_PROJ, RW_PROJ + MLA_PROJ
    for li in range(DEPTH):
        need_ctx = li < DEPTH - 1
        mod_l = (jax.nn.silu(c) @ mod_w[li] + mod_b[li])[:, None, :]
        mod_c = (jax.nn.silu(c_ctx) @ mod_w[li] + mod_b[li])[None, None, :]
        shm_l, scm_l, gm_l, shf_l, scf_l, gf_l = jnp.split(mod_l, N_MOD, axis=-1)
        shm_c, scm_c, gm_c, shf_c, scf_c, gf_c = jnp.split(mod_c, N_MOD, axis=-1)

        p_l = (rms_norm(x, mix_norm[li]) * (1.0 + scm_l) + shm_l) @ w_in[li]
        p_c = (rms_norm(ctx, mix_norm[li]) * (1.0 + scm_c) + shm_c) @ w_in[li]
        rw_l, rw_c = rwkv7_mixer(p_l[..., :s_rw], p_c[..., :s_rw], rw_conv[li], rw_decay_up[li], rw_decay0[li],
                                 rw_a_up[li], rw_a0[li], rw_gate_up[li], rw_k_k[li], rw_k_a[li], rw_r_k[li],
                                 rw_gn_g[li], rw_gn_b[li], need_ctx)
        ml_l, ml_c = mla_mixer(p_l[..., s_rw:s_mla], p_c[..., s_rw:s_mla], rope, mla_q_norm[li], mla_w_uq[li],
                               mla_kv_norm[li], mla_w_ukv[li], mla_q_gain[li], mla_k_gain[li], need_ctx)
        hy_prm = (hy_conv[li], hy_w1[li], hy_b1[li], hy_freq1[li], hy_w2[li], hy_b2[li], hy_freq2[li],
                  hy_w3[li], hy_b3[li], hy_bias[li])
        hy_l = hyena_mixer(p_l[..., s_mla:], *hy_prm)
        x = x + gm_l * (jnp.concatenate([rw_l, ml_l, hy_l], axis=-1) @ w_out[li])

        x = x + gf_l * peer_ffn(rms_norm(x, ffn_norm[li]) * (1.0 + scf_l) + shf_l,
                                peer_wq[li], peer_keys[li], peer_u[li], peer_v[li])

        if need_ctx:
            hy_c = hyena_mixer(p_c[..., s_mla:], *hy_prm)
            ctx = ctx + gm_c * (jnp.concatenate([rw_c, ml_c, hy_c], axis=-1) @ w_out[li])
            ctx = ctx + gf_c * peer_ffn(rms_norm(ctx, ffn_norm[li]) * (1.0 + scf_c) + shf_c,
                                        peer_wq[li], peer_keys[li], peer_u[li], peer_v[li])
    return x
```

```cpp
#include <hip/hip_runtime.h>
#include <hip/hip_cooperative_groups.h>
#include <cstdio>
namespace cg = cooperative_groups;

#ifndef DIAG
#define DIAG 0
#endif
#ifndef PROBE_D4
#define PROBE_D4 0
#endif
#ifndef PROBE_D3
#define PROBE_D3 0
#endif
#ifndef PROBE_AB
#define PROBE_AB 0
#endif
#ifndef PROBE_C
#define PROBE_C 0
#endif
#ifndef MULTI_LAUNCH
#define MULTI_LAUNCH 0
#endif

typedef unsigned short u16;
typedef __attribute__((ext_vector_type(8))) short bf16x8;
typedef __attribute__((ext_vector_type(4))) float f32x4;
typedef __attribute__((ext_vector_type(2))) float f32x2;
#define DEV __device__ __forceinline__

constexpr int D = 1024, TLAT = 32768, TCTX = 2048, TT = 34816, KTOT = 4352;
constexpr int NPH = 16;
constexpr int LDS_BYTES = 98304 + 256;
constexpr int GRID_BLOCKS_PER_CU = 2;

enum { I_X = 0, I_C, I_CTX, I_CCTX, I_MODW, I_MODB, I_MIXNORM, I_WIN, I_WOUT, I_RWCONV, I_RWDUP, I_RWD0, I_RWAUP, I_RWA0,
       I_RWGUP, I_RWKK, I_RWKA, I_RWRK, I_RWGNG, I_RWGNB, I_MQNORM, I_MWUQ, I_MKVNORM, I_MWUKV, I_MQGAIN, I_MKGAIN,
       I_HYCONV, I_HYW1, I_HYB1, I_HYF1, I_HYW2, I_HYB2, I_HYF2, I_HYW3, I_HYB3, I_HYBIAS, I_FFNNORM, I_PWQ, I_PKEYS, I_PU, I_PV, N_IN };

struct Params { const float* in[N_IN]; float* out; unsigned char* ws; };

constexpr size_t OFF_CTR  = 0;
constexpr size_t OFF_WIN  = 256;
constexpr size_t OFF_WOUT = OFF_WIN  + 2ull * 2688 * 1024 * 2;
constexpr size_t OFF_WQ   = OFF_WOUT + 2ull * 1024 * 1024 * 2;
constexpr size_t OFF_WUQ  = OFF_WQ   + 2ull * 2048 * 1024 * 2;
constexpr size_t OFF_WUKV = OFF_WUQ  + 2ull * 576 * 256 * 2;
constexpr size_t OFF_DUT  = OFF_WUKV + 2ull * 768 * 128 * 2;
constexpr size_t OFF_AUT  = OFF_DUT  + 4ull * 384 * 64 * 2;
constexpr size_t OFF_GUT  = OFF_AUT  + 4ull * 384 * 64 * 2;
constexpr size_t OFF_KEYS = OFF_GUT  + 2ull * 384 * 128 * 2;
constexpr size_t OFF_MOD  = OFF_KEYS + 2ull * 8 * 2 * 128 * 128 * 2;
constexpr size_t OFF_H2   = OFF_MOD  + 2ull * 9 * 6144 * 4;
constexpr size_t OFF_TW   = OFF_H2   + 2ull * 4352 * 64 * 4;
constexpr size_t OFF_ROPE = OFF_TW   + 4096ull * 8;
constexpr size_t OFF_HF   = OFF_ROPE + 2ull * 4096 * 16 * 4;
constexpr size_t OFF_XCTX = OFF_HF   + 2ull * 256 * 8192 * 8 + 2ull * 256 * 512 * 8;
constexpr size_t OFF_PRW  = OFF_XCTX + 2048ull * 1024 * 4;
constexpr size_t OFF_PMH  = OFF_PRW  + (size_t)TT * 1408 * 2;
constexpr size_t OFF_ATT  = OFF_PMH;
constexpr size_t OFF_HYO  = OFF_ATT  + (size_t)TT * 384 * 2;
constexpr size_t OFF_Y0   = OFF_HYO  + (size_t)TT * 256 * 2;
constexpr size_t OFF_QB   = OFF_PMH  + (size_t)TT * 1184 * 2;
constexpr size_t OFF_KB   = OFF_QB   + 48ull * KTOT * 96 * 2;
constexpr size_t OFF_VT   = OFF_KB   + 48ull * KTOT * 96 * 2;
constexpr size_t OFF_XN   = OFF_QB;
constexpr size_t OFF_EIDX = OFF_XN   + (size_t)TT * 1024 * 2;
constexpr size_t OFF_GATE = OFF_EIDX + (size_t)TT * 128 * 4;
constexpr size_t OFF_HYIN = OFF_VT   + 48ull * 64 * KTOT * 2;
constexpr size_t OFF_G    = OFF_HYIN + 3ull * TT * 256 * 2;
constexpr size_t OFF_BG   = OFF_G    + (size_t)TT * 384 * 2;
constexpr size_t OFF_Y1   = OFF_BG   + (size_t)TT * 384 * 2;
constexpr size_t WS_END   = OFF_Y1   + (size_t)TT * 384 * 2;
static_assert(OFF_GATE + (size_t)TT * 128 * 4 <= OFF_HYIN, "alias overflow");
static_assert(OFF_Y0 + (size_t)TT * 384 * 2 <= OFF_QB, "alias overflow 2");
constexpr size_t OFF_BAR = WS_END;
constexpr size_t WS_NEED = WS_END + 4096;
static_assert(WS_NEED <= 536870912ull, "workspace too large");

DEV u16 f2bf(float f) { unsigned r; asm("v_cvt_pk_bf16_f32 %0, %1, %1" : "=v"(r) : "v"(f)); return (u16)(r & 0xffffu); }
DEV float bf2f(u16 h) { return __uint_as_float(((unsigned)h) << 16); }
DEV unsigned pack2(float a, float b) { unsigned r; asm("v_cvt_pk_bf16_f32 %0, %1, %2" : "=v"(r) : "v"(a), "v"(b)); return r; }
DEV float lo2f(unsigned u) { return __uint_as_float(u << 16); }
DEV float hi2f(unsigned u) { return __uint_as_float(u & 0xffff0000u); }
DEV uint4 pack8(const float* f) { uint4 r; r.x = pack2(f[0], f[1]); r.y = pack2(f[2], f[3]); r.z = pack2(f[4], f[5]); r.w = pack2(f[6], f[7]); return r; }
DEV void unpack8(uint4 v, float* f) { f[0] = lo2f(v.x); f[1] = hi2f(v.x); f[2] = lo2f(v.y); f[3] = hi2f(v.y); f[4] = lo2f(v.z); f[5] = hi2f(v.z); f[6] = lo2f(v.w); f[7] = hi2f(v.w); }
DEV float sigmoidf_(float x) { return 1.f / (1.f + __expf(-x)); }

template <int CTRL> DEV float dppf(float x) { return __int_as_float(__builtin_amdgcn_update_dpp(0, __float_as_int(x), CTRL, 0xf, 0xf, false)); }
template <int CTRL> DEV int dppi(int x) { return __builtin_amdgcn_update_dpp(0, x, CTRL, 0xf, 0xf, false); }
DEV float sum4(float v) { v += dppf<0xB1>(v); v += dppf<0x4E>(v); return v; }
DEV float sum8(float v) { v = sum4(v); v += dppf<0x141>(v); return v; }
DEV float sum16(float v) { v = sum8(v); v += dppf<0x140>(v); return v; }
DEV float wave_sum(float v) { v = sum16(v); v += __shfl_xor(v, 16); v += __shfl_xor(v, 32); return v; }
DEV bf16x8 as_bf8(uint4 v) { union { uint4 u; bf16x8 b; } x; x.u = v; return x.b; }
DEV f32x4 mfma16(bf16x8 a, bf16x8 b, f32x4 c) { return __builtin_amdgcn_mfma_f32_16x16x32_bf16(a, b, c, 0, 0, 0); }
DEV float dot2bf(unsigned a, unsigned b, float c) { asm("v_dot2c_f32_bf16 %0, %1, %2" : "+v"(c) : "v"(a), "v"(b)); return c; }
DEV float fsin(float x) { return __builtin_amdgcn_sinf(x * 0.15915494309189535f); }
DEV float fcos(float x) { return __builtin_amdgcn_cosf(x * 0.15915494309189535f); }

DEV int opaque_tid() { int t = threadIdx.x; asm volatile("" : "+v"(t)); return t; }
DEV int tok_mv(int tok) { return tok < TLAT ? (tok >> 12) : 8; }
DEV const float* xsrc(const Params& p, int tok, bool orig) {
  if (tok < TLAT) return (orig ? p.in[I_X] : p.out) + (size_t)tok * D;
  return (orig ? p.in[I_CTX] : (const float*)(p.ws + OFF_XCTX)) + (size_t)(tok - TLAT) * D;
}
DEV float* xdst(const Params& p, int tok) {
  if (tok < TLAT) return p.out + (size_t)tok * D;
  return (float*)(p.ws + OFF_XCTX) + (size_t)(tok - TLAT) * D;
}
DEV const float* modp(const Params& p, int li, int mv, int chunk) { return (const float*)(p.ws + OFF_MOD) + ((size_t)(li * 9 + mv) * 6 + chunk) * 1024; }

DEV void conv8(const u16* P, int ld, int tok, bool hp, bool hn, int col, const float* cw, int cwld, float* out) {
  const u16* r = P + (size_t)tok * ld + col;
  uint4 z = make_uint4(0, 0, 0, 0);
  uint4 v1 = *(const uint4*)r;
  uint4 v0 = hp ? *(const uint4*)(r - ld) : z;
  uint4 v2 = hn ? *(const uint4*)(r + ld) : z;
  float a[8], b[8], c[8];
  unpack8(v0, a); unpack8(v1, b); unpack8(v2, c);
  float4 w0a = *(const float4*)(cw), w0b = *(const float4*)(cw + 4);
  float4 w1a = *(const float4*)(cw + cwld), w1b = *(const float4*)(cw + cwld + 4);
  float4 w2a = *(const float4*)(cw + 2 * cwld), w2b = *(const float4*)(cw + 2 * cwld + 4);
  const float w0[8] = {w0a.x, w0a.y, w0a.z, w0a.w, w0b.x, w0b.y, w0b.z, w0b.w};
  const float w1[8] = {w1a.x, w1a.y, w1a.z, w1a.w, w1b.x, w1b.y, w1b.z, w1b.w};
  const float w2[8] = {w2a.x, w2a.y, w2a.z, w2a.w, w2b.x, w2b.y, w2b.z, w2b.w};
#pragma unroll
  for (int j = 0; j < 8; ++j) out[j] = a[j] * w0[j] + b[j] * w1[j] + c[j] * w2[j];
}
DEV void tok_nb(int tok, bool& hp, bool& hn) {
  if (tok < TLAT) { int t = tok & 4095; hp = t > 0; hn = t < 4095; }
  else { int t = (tok - TLAT) & 255; hp = t > 0; hn = t < 255; }
}

template <int BM, int BN, int WM, int WN, class AL, class BL, class EP>
DEV void gemm_tile(unsigned char* lds, int K, AL aload, BL bload, EP epi) {
  constexpr int LDT = 72;
  constexpr int TM = BM / WM / 16, TN = BN / WN / 16;
  constexpr int NA = BM * 8 / 256, NBc = BN * 8 / 256;
  u16* As = (u16*)lds;
  u16* Bs = As + BM * LDT;
  const int tid = opaque_tid(), lane = tid & 63, wave = tid >> 6;
  const int wm = wave / WN, wn = wave % WN;
  const int c = lane & 15, quad = lane >> 4;
  f32x4 acc[TM][TN];
#pragma unroll
  for (int i = 0; i < TM; ++i)
#pragma unroll
    for (int j = 0; j < TN; ++j) acc[i][j] = (f32x4){0.f, 0.f, 0.f, 0.f};
  uint4 ra[NA], rb[NBc];
#pragma unroll
  for (int i = 0; i < NA; ++i) { int id = tid + 256 * i; ra[i] = aload(id >> 3, (id & 7) * 8); }
#pragma unroll
  for (int i = 0; i < NBc; ++i) { int id = tid + 256 * i; rb[i] = bload(id >> 3, (id & 7) * 8); }
  const int nk = K / 64;
  for (int kt = 0; kt < nk; ++kt) {
    __syncthreads();
#pragma unroll
    for (int i = 0; i < NA; ++i) { int id = tid + 256 * i; *(uint4*)(As + (id >> 3) * LDT + (id & 7) * 8) = ra[i]; }
#pragma unroll
    for (int i = 0; i < NBc; ++i) { int id = tid + 256 * i; *(uint4*)(Bs + (id >> 3) * LDT + (id & 7) * 8) = rb[i]; }
    __syncthreads();
    if (kt + 1 < nk) {
      const int k0 = (kt + 1) * 64;
#pragma unroll
      for (int i = 0; i < NA; ++i) { int id = tid + 256 * i; ra[i] = aload(id >> 3, k0 + (id & 7) * 8); }
#pragma unroll
      for (int i = 0; i < NBc; ++i) { int id = tid + 256 * i; rb[i] = bload(id >> 3, k0 + (id & 7) * 8); }
    }
#pragma unroll (TN >= 8 ? 1 : 2)
    for (int ks = 0; ks < 2; ++ks) {
      bf16x8 af[TM], bfr[TN];
#pragma unroll
      for (int i = 0; i < TM; ++i) af[i] = *(const bf16x8*)(As + (wm * (BM / WM) + i * 16 + c) * LDT + ks * 32 + quad * 8);
#pragma unroll
      for (int j = 0; j < TN; ++j) bfr[j] = *(const bf16x8*)(Bs + (wn * (BN / WN) + j * 16 + c) * LDT + ks * 32 + quad * 8);
#pragma unroll
      for (int i = 0; i < TM; ++i)
#pragma unroll
        for (int j = 0; j < TN; ++j) acc[i][j] = mfma16(af[i], bfr[j], acc[i][j]);
    }
  }
  __syncthreads();
#pragma unroll
  for (int i = 0; i < TM; ++i)
#pragma unroll
    for (int j = 0; j < TN; ++j) epi(wm * (BM / WM) + i * 16 + quad * 4, wn * (BN / WN) + j * 16 + c, acc[i][j]);
}

DEV void transpose_item(const float* W, int K, int N, u16* Wt, int item, unsigned char* lds, int ntn) {
  float* tile = (float*)lds;
  const int kb = item / ntn, nb = item % ntn;
  const int tid = opaque_tid();
  __syncthreads();
#pragma unroll
  for (int i = 0; i < 16; ++i) {
    int kk = i * 4 + (tid >> 6), nn = tid & 63;
    int n = nb * 64 + nn;
    tile[kk * 65 + nn] = (n < N) ? W[(size_t)(kb * 64 + kk) * N + n] : 0.f;
  }
  __syncthreads();
  const int nl = tid >> 2, kq = tid & 3;
  float f[16];
#pragma unroll
  for (int j = 0; j < 16; ++j) f[j] = tile[(kq * 16 + j) * 65 + nl];
  u16* dst = Wt + (size_t)(nb * 64 + nl) * K + kb * 64 + kq * 16;
  *(uint4*)dst = pack8(f);
  *(uint4*)(dst + 8) = pack8(f + 8);
}

DEV void phase0a(const Params& p, unsigned char* lds) {
  const int tid = opaque_tid();
  if (blockIdx.x == 0 && tid < 64) ((unsigned*)(p.ws + OFF_CTR))[tid] = 0u;
  if (blockIdx.x == 0) { for (int i = tid; i < 1024; i += 256) ((unsigned*)(p.ws + OFF_BAR))[i] = 0u; }
  constexpr int J_WIN = 2 * 16 * 42, J_WOUT = 2 * 16 * 16, J_WQ = 2 * 16 * 32, J_WUQ = 2 * 4 * 9, J_WUKV = 2 * 2 * 12,
                J_DU = 4 * 6, J_AU = 4 * 6, J_GU = 2 * 2 * 6, J_KEYS = 256, J_MOD = 192, J_H2 = 2176, J_TW = 16, J_ROPE = 256;
  constexpr int TOTAL = J_WIN + J_WOUT + J_WQ + J_WUQ + J_WUKV + J_DU + J_AU + J_GU + J_KEYS + J_MOD + J_H2 + J_TW + J_ROPE;
  for (int item = blockIdx.x; item < TOTAL; item += gridDim.x) {
    int r = item;
    if (r < J_WIN) { int li = r / 672; r %= 672; transpose_item(p.in[I_WIN] + (size_t)li * 1024 * 2592, 1024, 2592, (u16*)(p.ws + OFF_WIN) + (size_t)li * 2688 * 1024, r, lds, 42); continue; } r -= J_WIN;
    if (r < J_WOUT) { int li = r / 256; r %= 256; transpose_item(p.in[I_WOUT] + (size_t)li * 1024 * 1024, 1024, 1024, (u16*)(p.ws + OFF_WOUT) + (size_t)li * 1024 * 1024, r, lds, 16); continue; } r -= J_WOUT;
    if (r < J_WQ) { int li = r / 512; r %= 512; transpose_item(p.in[I_PWQ] + (size_t)li * 1024 * 2048, 1024, 2048, (u16*)(p.ws + OFF_WQ) + (size_t)li * 2048 * 1024, r, lds, 32); continue; } r -= J_WQ;
    if (r < J_WUQ) { int li = r / 36; r %= 36; transpose_item(p.in[I_MWUQ] + (size_t)li * 256 * 576, 256, 576, (u16*)(p.ws + OFF_WUQ) + (size_t)li * 576 * 256, r, lds, 9); continue; } r -= J_WUQ;
    if (r < J_WUKV) { int li = r / 24; r %= 24; transpose_item(p.in[I_MWUKV] + (size_t)li * 128 * 768, 128, 768, (u16*)(p.ws + OFF_WUKV) + (size_t)li * 768 * 128, r, lds, 12); continue; } r -= J_WUKV;
    if (r < J_DU) { int m = r / 6; r %= 6; transpose_item(p.in[I_RWDUP] + (size_t)m * 64 * 384, 64, 384, (u16*)(p.ws + OFF_DUT) + (size_t)m * 384 * 64, r, lds, 6); continue; } r -= J_DU;
    if (r < J_AU) { int m = r / 6; r %= 6; transpose_item(p.in[I_RWAUP] + (size_t)m * 64 * 384, 64, 384, (u16*)(p.ws + OFF_AUT) + (size_t)m * 384 * 64, r, lds, 6); continue; } r -= J_AU;
    if (r < J_GU) { int li = r / 12; r %= 12; transpose_item(p.in[I_RWGUP] + (size_t)li * 128 * 384, 128, 384, (u16*)(p.ws + OFF_GUT) + (size_t)li * 384 * 128, r, lds, 6); continue; } r -= J_GU;
    if (r < J_KEYS) {
      const float* src = p.in[I_PKEYS] + (size_t)r * 2048 + tid * 8;
      float4 a = *(const float4*)src, b = *(const float4*)(src + 4);
      float f[8] = {a.x, a.y, a.z, a.w, b.x, b.y, b.z, b.w};
      *(uint4*)((u16*)(p.ws + OFF_KEYS) + (size_t)r * 2048 + tid * 8) = pack8(f);
      continue;
    } r -= J_KEYS;
    if (r < J_MOD) {
      const int li = r / 96, n0 = (r % 96) * 64;
      float* sc = (float*)lds;
      float* red = sc + 9 * 1024;
      __syncthreads();
      for (int i = tid; i < 9 * 1024; i += 256) {
        int mv = i >> 10, k = i & 1023;
        float v = (mv < 8) ? p.in[I_C][mv * 1024 + k] : p.in[I_CCTX][k];
        sc[i] = v * sigmoidf_(v);
      }
      __syncthreads();
      const int lane = tid & 63, wave = tid >> 6;
      float acc[9];
#pragma unroll
      for (int m = 0; m < 9; ++m) acc[m] = 0.f;
      const float* w = p.in[I_MODW] + (size_t)li * 1024 * 6144 + n0 + lane;
#pragma unroll 16
      for (int k = wave * 256; k < wave * 256 + 256; ++k) {
        float wv = w[(size_t)k * 6144];
#pragma unroll
        for (int m = 0; m < 9; ++m) acc[m] += sc[m * 1024 + k] * wv;
      }
#pragma unroll
      for (int m = 0; m < 9; ++m) red[(wave * 9 + m) * 64 + lane] = acc[m];
      __syncthreads();
      for (int i = tid; i < 9 * 64; i += 256) {
        int m = i >> 6, l = i & 63;
        float s = red[(0 * 9 + m) * 64 + l] + red[(1 * 9 + m) * 64 + l] + red[(2 * 9 + m) * 64 + l] + red[(3 * 9 + m) * 64 + l];
        ((float*)(p.ws + OFF_MOD))[(size_t)(li * 9 + m) * 6144 + n0 + l] = s + p.in[I_MODB][li * 6144 + n0 + l];
      }
      continue;
    } r -= J_MOD;
    if (r < J_H2) {
      const int li = r / 1088; const int q4 = r % 1088;
      const int tl = tid >> 6, j = tid & 63;
      const int row = q4 * 4 + tl;
      const float tn = row < 4096 ? (float)row / 4096.f : (float)(row - 4096) / 256.f;
      float* h1s = (float*)lds;
      __syncthreads();
      const float* w1 = p.in[I_HYW1] + (size_t)li * 33 * 64;
      float a = tn * w1[j];
#pragma unroll 4
      for (int k = 1; k <= 16; ++k) {
        float rev = tn * (float)k;
        a += __builtin_amdgcn_cosf(rev) * w1[k * 64 + j] + __builtin_amdgcn_sinf(rev) * w1[(16 + k) * 64 + j];
      }
      a = fsin(p.in[I_HYF1][li * 64 + j] * (a + p.in[I_HYB1][li * 64 + j]));
      h1s[tl * 64 + j] = a;
      __syncthreads();
      const float* w2 = p.in[I_HYW2] + (size_t)li * 64 * 64;
      float b = 0.f;
#pragma unroll 8
      for (int i = 0; i < 64; ++i) b += h1s[tl * 64 + i] * w2[i * 64 + j];
      b = fsin(p.in[I_HYF2][li * 64 + j] * (b + p.in[I_HYB2][li * 64 + j]));
      ((float*)(p.ws + OFF_H2))[((size_t)li * 4352 + row) * 64 + j] = b;
      continue;
    } r -= J_H2;
    if (r < J_TW) {
      int k = r * 256 + tid;
      float rev = (float)k / 8192.f;
      float2 w; w.x = __builtin_amdgcn_cosf(rev); w.y = -__builtin_amdgcn_sinf(rev);
      ((float2*)(p.ws + OFF_TW))[k] = w;
      continue;
    } r -= J_TW;
    {
      int e = r * 256 + tid;
      int l = e >> 4, ai = e & 15, a = ai >> 3, i = ai & 7;
      float pos = a == 0 ? (float)(l >> 6) : (float)(l & 63);
      float inv = exp2f(-(float)i * (13.287712379549449f / 8.f));
      float ang = pos * inv;
      ((float*)(p.ws + OFF_ROPE))[e] = fcos(ang);
      ((float*)(p.ws + OFF_ROPE))[65536 + e] = fsin(ang);
    }
  }
}

DEV void norm_row_store(const float* xr, const float* gain, const float* sc, const float* sh, u16* dst, int lane) {
  float4 v[4]; float ss = 0.f;
#pragma unroll
  for (int j = 0; j < 4; ++j) { v[j] = *(const float4*)(xr + j * 256 + lane * 4); ss += v[j].x * v[j].x + v[j].y * v[j].y + v[j].z * v[j].z + v[j].w * v[j].w; }
  ss = wave_sum(ss);
  const float rstd = rsqrtf(ss * (1.f / 1024.f) + 1e-6f);
#pragma unroll
  for (int j = 0; j < 4; ++j) {
    const int n = j * 256 + lane * 4;
    float4 g = *(const float4*)(gain + n), s = *(const float4*)(sc + n), h = *(const float4*)(sh + n);
    uint2 o;
    o.x = pack2(v[j].x * rstd * g.x * (1.f + s.x) + h.x, v[j].y * rstd * g.y * (1.f + s.y) + h.y);
    o.y = pack2(v[j].z * rstd * g.z * (1.f + s.z) + h.z, v[j].w * rstd * g.w * (1.f + s.w) + h.w);
    *(uint2*)(dst + n) = o;
  }
}
DEV void norm_pass(const Params& p, int li, bool orig, const float* gain, int sc_chunk, int sh_chunk, int ntok) {
  const int tid_ = opaque_tid(); const int lane = tid_ & 63, wave = tid_ >> 6;
#pragma unroll 2
  for (int item = blockIdx.x; item < ntok / 4; item += gridDim.x) {
    const int tok = item * 4 + wave;
    const int mv = tok_mv(tok);
    norm_row_store(xsrc(p, tok, orig), gain, modp(p, li, mv, sc_chunk), modp(p, li, mv, sh_chunk), (u16*)(p.ws + OFF_XN) + (size_t)tok * D, lane);
  }
}

DEV float2 cmul(float2 a, float2 b) { return make_float2(a.x * b.x - a.y * b.y, a.x * b.y + a.y * b.x); }
DEV float2* stage_tw(const Params& p, unsigned char* lds) {
  float2* TWs = (float2*)(lds + 65536);
  const float2* TWg = (const float2*)(p.ws + OFF_TW);
  const int tid = opaque_tid();
  __syncthreads();
  for (int i = tid; i < 4096; i += 256) TWs[i] = TWg[i];
  __syncthreads();
  return TWs;
}
DEV float2 cadd(float2 a, float2 b) { return make_float2(a.x + b.x, a.y + b.y); }
DEV float2 csub(float2 a, float2 b) { return make_float2(a.x - b.x, a.y - b.y); }
DEV float2 cconj(float2 a) { return make_float2(a.x, -a.y); }
DEV void fft_fwd(float2* buf, int logn, const float2* TW) {
  const int tid = opaque_tid();
  const int sh = 13 - logn, nq = 1 << (logn - 2);
  for (int s = logn - 1; s >= 1; s -= 2) {
    const int h1 = 1 << s, h2 = h1 >> 1;
#pragma unroll 2
    for (int i = tid; i < nq; i += 256) {
      const int p = i & (h2 - 1);
      const int a = ((i >> (s - 1)) << (s + 1)) + p;
      const float2 w1a = TW[(p << (logn - 1 - s)) << sh], w1b = TW[((p + h2) << (logn - 1 - s)) << sh], w2 = TW[(p << (logn - s)) << sh];
      const float2 x0 = buf[a], x1 = buf[a + h2], x2 = buf[a + h1], x3 = buf[a + h1 + h2];
      const float2 y0 = cadd(x0, x2), y2 = cmul(csub(x0, x2), w1a);
      const float2 y1 = cadd(x1, x3), y3 = cmul(csub(x1, x3), w1b);
      buf[a] = cadd(y0, y1); buf[a + h2] = cmul(csub(y0, y1), w2);
      buf[a + h1] = cadd(y2, y3); buf[a + h1 + h2] = cmul(csub(y2, y3), w2);
    }
    __syncthreads();
  }
  {
    const int nh = 1 << (logn - 1);
#pragma unroll 2
    for (int i = tid; i < nh; i += 256) {
      const float2 x = buf[2 * i], y = buf[2 * i + 1];
      buf[2 * i] = cadd(x, y); buf[2 * i + 1] = csub(x, y);
    }
    __syncthreads();
  }
}
DEV void fft_inv(float2* buf, int logn, const float2* TW) {
  const int tid = opaque_tid();
  const int sh = 13 - logn, nq = 1 << (logn - 2);
  {
    const int nh = 1 << (logn - 1);
#pragma unroll 2
    for (int i = tid; i < nh; i += 256) {
      const float2 x = buf[2 * i], y = buf[2 * i + 1];
      buf[2 * i] = cadd(x, y); buf[2 * i + 1] = csub(x, y);
    }
    __syncthreads();
  }
  for (int s = 2; s <= logn - 1; s += 2) {
    const int h1 = 1 << s, h2 = h1 >> 1;
#pragma unroll 2
    for (int i = tid; i < nq; i += 256) {
      const int p = i & (h2 - 1);
      const int a = ((i >> (s - 1)) << (s + 1)) + p;
      const float2 w1a = cconj(TW[(p << (logn - 1 - s)) << sh]), w1b = cconj(TW[((p + h2) << (logn - 1 - s)) << sh]), w2 = cconj(TW[(p << (logn - s)) << sh]);
      const float2 z0 = buf[a], z1 = buf[a + h2], z2 = buf[a + h1], z3 = buf[a + h1 + h2];
      const float2 t1 = cmul(z1, w2), t3 = cmul(z3, w2);
      const float2 y0 = cadd(z0, t1), y1 = csub(z0, t1), y2 = cadd(z2, t3), y3 = csub(z2, t3);
      const float2 u2 = cmul(y2, w1a), u3 = cmul(y3, w1b);
      buf[a] = cadd(y0, u2); buf[a + h1] = csub(y0, u2);
      buf[a + h2] = cadd(y1, u3); buf[a + h1 + h2] = csub(y1, u3);
    }
    __syncthreads();
  }
}

DEV void mla_item(const Params& p, int li, int item, unsigned char* lds) {
  const int tid = opaque_tid(), lane = tid & 63, wave = tid >> 6;
  const int tok0 = item * 64 + wave * 16;
  __syncthreads();
  u16* Aq = (u16*)(lds + wave * 15360);
  u16* Akv = Aq + 16 * 264;
  float* KR = (float*)(Akv + 16 * 136);
  float* SSR = KR + 16 * 32;
  const u16* Pmh = (const u16*)(p.ws + OFF_PMH);
  const bool lat = tok0 < TLAT;
  const int b = lat ? (tok0 >> 12) : ((tok0 - TLAT) >> 8);
  const int kidx0 = lat ? (tok0 & 4095) : (4096 + ((tok0 - TLAT) & 255));
  {
    const int row = lane >> 2, sub = lane & 3;
    const u16* rp = Pmh + (size_t)(tok0 + row) * 1184;
    uint4 v[13];
#pragma unroll
    for (int i = 0; i < 13; ++i) v[i] = *(const uint4*)(rp + (sub + 4 * i) * 8);
    float ssq = 0.f, sskv = 0.f, ssr = 0.f;
    float f[8];
#pragma unroll
    for (int i = 0; i < 13; ++i) {
      unpack8(v[i], f);
      float s = 0.f;
#pragma unroll
      for (int j = 0; j < 8; ++j) s += f[j] * f[j];
      if (i < 8) ssq += s; else if (i < 12) sskv += s; else ssr += s;
    }
    ssq = sum4(ssq); sskv = sum4(sskv); ssr = sum4(ssr);
    const float rq = rsqrtf(ssq * (1.f / 256.f) + 1e-6f), rkv = rsqrtf(sskv * (1.f / 128.f) + 1e-6f);
    const float* qn = p.in[I_MQNORM] + li * 256;
    const float* kvn = p.in[I_MKVNORM] + li * 128;
#pragma unroll
    for (int i = 0; i < 13; ++i) {
      unpack8(v[i], f);
      if (i < 8) {
        const int col = (sub + 4 * i) * 8;
#pragma unroll
        for (int j = 0; j < 8; ++j) f[j] = f[j] * rq * qn[col + j];
        *(uint4*)(Aq + row * 264 + col) = pack8(f);
      } else if (i < 12) {
        const int col = (sub + 4 * i - 32) * 8;
#pragma unroll
        for (int j = 0; j < 8; ++j) f[j] = f[j] * rkv * kvn[col + j];
        *(uint4*)(Akv + row * 136 + col) = pack8(f);
      } else {
#pragma unroll
        for (int j = 0; j < 8; ++j) KR[row * 32 + sub * 8 + j] = f[j];
      }
    }
    if (sub == 0) SSR[row] = ssr;
  }
  __builtin_amdgcn_fence(__ATOMIC_RELEASE, "wavefront");
  __builtin_amdgcn_wave_barrier();
  __builtin_amdgcn_fence(__ATOMIC_ACQUIRE, "wavefront");
  const int c = lane & 15, quad = lane >> 4;
  const float* RC = (const float*)(p.ws + OFF_ROPE);
  const float* RS = RC + 65536;
  const float QSCALE = 0.10206207261596577f * 1.4426950408889634f;
  u16* QB = (u16*)(p.ws + OFF_QB);
  u16* KB = (u16*)(p.ws + OFF_KB);
  u16* VT = (u16*)(p.ws + OFF_VT);
  {
    const u16* W = (const u16*)(p.ws + OFF_WUQ) + (size_t)li * 576 * 256;
    const float* qg = p.in[I_MQGAIN] + li * 96;
#pragma unroll 1
    for (int h = 0; h < 6; ++h) {
      f32x4 acc[6];
#pragma unroll
      for (int j = 0; j < 6; ++j) acc[j] = (f32x4){0.f, 0.f, 0.f, 0.f};
#pragma unroll
      for (int ks = 0; ks < 8; ++ks) {
        const bf16x8 af = *(const bf16x8*)(Aq + c * 264 + ks * 32 + quad * 8);
#pragma unroll
        for (int j = 0; j < 6; ++j) {
          bf16x8 bb = *(const bf16x8*)(W + (size_t)(h * 96 + j * 16 + c) * 256 + ks * 32 + quad * 8);
          acc[j] = mfma16(af, bb, acc[j]);
        }
      }
#pragma unroll
      for (int r = 0; r < 4; ++r) {
        float s = 0.f;
#pragma unroll
        for (int j = 0; j < 6; ++j) s += acc[j][r] * acc[j][r];
        s = sum16(s);
        const float rs = rsqrtf(s * (1.f / 96.f) + 1e-6f) * QSCALE;
        const int rowi = quad * 4 + r;
        u16* dst = QB + ((size_t)(b * 6 + h) * KTOT + kidx0 + rowi) * 96;
#pragma unroll
        for (int j = 0; j < 4; ++j) dst[j * 16 + c] = f2bf(acc[j][r] * rs * qg[j * 16 + c]);
#pragma unroll
        for (int j = 4; j < 6; ++j) {
          float x = acc[j][r] * rs * qg[j * 16 + c];
          if (lat) {
            const float pr = __shfl_xor(x, 8);
            const int t = kidx0 + rowi;
            const float cs = RC[t * 16 + (j - 4) * 8 + (c & 7)], sn = RS[t * 16 + (j - 4) * 8 + (c & 7)];
            x = (c < 8) ? (x * cs - pr * sn) : (x * cs + pr * sn);
          }
          dst[j * 16 + c] = f2bf(x);
        }
      }
    }
  }
  {
    const u16* W = (const u16*)(p.ws + OFF_WUKV) + (size_t)li * 768 * 128;
    const float* kg = p.in[I_MKGAIN] + li * 96;
#pragma unroll 1
    for (int h = 0; h < 6; ++h) {
      f32x4 acc[8];
#pragma unroll
      for (int j = 0; j < 8; ++j) acc[j] = (f32x4){0.f, 0.f, 0.f, 0.f};
#pragma unroll
      for (int ks = 0; ks < 4; ++ks) {
        const bf16x8 af = *(const bf16x8*)(Akv + c * 136 + ks * 32 + quad * 8);
#pragma unroll
        for (int j = 0; j < 8; ++j) {
          bf16x8 bb = *(const bf16x8*)(W + (size_t)(h * 128 + j * 16 + c) * 128 + ks * 32 + quad * 8);
          acc[j] = mfma16(af, bb, acc[j]);
        }
      }
#pragma unroll
      for (int r = 0; r < 4; ++r) {
        const int rowi = quad * 4 + r;
        float s = 0.f;
#pragma unroll
        for (int j = 0; j < 4; ++j) s += acc[j][r] * acc[j][r];
        s = sum16(s);
        s += SSR[rowi];
        const float rk = rsqrtf(s * (1.f / 96.f) + 1e-6f);
        u16* dk = KB + ((size_t)(b * 6 + h) * KTOT + kidx0 + rowi) * 96;
#pragma unroll
        for (int j = 0; j < 4; ++j) dk[j * 16 + c] = f2bf(acc[j][r] * rk * kg[j * 16 + c]);
#pragma unroll
        for (int jj = 0; jj < 2; ++jj) {
          float x = KR[rowi * 32 + jj * 16 + c] * rk * kg[64 + jj * 16 + c];
          if (lat) {
            const float pr = KR[rowi * 32 + jj * 16 + (c ^ 8)] * rk * kg[64 + jj * 16 + (c ^ 8)];
            const int t = kidx0 + rowi;
            const float cs = RC[t * 16 + jj * 8 + (c & 7)], sn = RS[t * 16 + jj * 8 + (c & 7)];
            x = (c < 8) ? (x * cs - pr * sn) : (x * cs + pr * sn);
          }
          dk[64 + jj * 16 + c] = f2bf(x);
        }
#pragma unroll
        for (int j = 0; j < 4; ++j) VT[((size_t)(b * 6 + h) * 64 + j * 16 + c) * KTOT + kidx0 + rowi] = f2bf(acc[4 + j][r]);
      }
    }
  }
  __builtin_amdgcn_wave_barrier();
}

DEV void hy_item(const Params& p, int li, int part, int tt, unsigned char* lds) {
  const int tid = opaque_tid();
  u16* Z = (u16*)lds;
  int b, t0, L, tokbase; size_t obase;
  if (tt < 512) { b = tt >> 6; t0 = (tt & 63) * 64; L = 4096; tokbase = b * 4096; obase = (size_t)b * 256 * 4096; }
  else { int u = tt - 512; b = u >> 2; t0 = (u & 3) * 64; L = 256; tokbase = TLAT + b * 256; obase = (size_t)8 * 256 * 4096 + (size_t)b * 256 * 256; }
  const u16* Pmh = (const u16*)(p.ws + OFF_PMH);
  __syncthreads();
  for (int id = tid; id < 66 * 32; id += 256) {
    const int rr = id >> 5, ch = id & 31;
    const int t = t0 - 1 + rr;
    uint4 v = make_uint4(0, 0, 0, 0);
    if (t >= 0 && t < L) v = *(const uint4*)(Pmh + (size_t)(tokbase + t) * 1184 + 416 + part * 256 + ch * 8);
    *(uint4*)(Z + rr * 264 + ch * 8) = v;
  }
  __syncthreads();
  const int c = tid;
  const float* cw = p.in[I_HYCONV] + (size_t)li * 3 * 768 + part * 256 + c;
  const float w0 = cw[0], w1 = cw[768], w2 = cw[1536];
  u16* dst = (u16*)(p.ws + OFF_HYIN) + (size_t)part * TT * 256 + obase + (size_t)c * L + t0;
#pragma unroll
  for (int g = 0; g < 8; ++g) {
    float f[8];
#pragma unroll
    for (int j = 0; j < 8; ++j) {
      const int t = g * 8 + j;
      f[j] = w0 * bf2f(Z[t * 264 + c]) + w1 * bf2f(Z[(t + 1) * 264 + c]) + w2 * bf2f(Z[(t + 2) * 264 + c]);
    }
    *(uint4*)(dst + g * 8) = pack8(f);
  }
}

DEV void rwg_item(const Params& p, int li, int item, unsigned char* lds) {
  const int tid = opaque_tid(), lane = tid & 63, wave = tid >> 6;
  const int tok0 = item * 64 + wave * 16;
  __syncthreads();
  u16* Ag = (u16*)(lds + wave * 16384);
  u16* BV = Ag + 16 * 128;
  const u16* Prw = (const u16*)(p.ws + OFF_PRW);
  const float* cw = p.in[I_RWCONV] + (size_t)li * 3 * 1408;
#pragma unroll
  for (int i = 0; i < 4; ++i) {
    const int unit = lane + 64 * i, row = unit >> 4, c8 = unit & 15;
    const int tok = tok0 + row; bool hp, hn; tok_nb(tok, hp, hn);
    float f[8];
    conv8(Prw, 1408, tok, hp, hn, 1280 + c8 * 8, cw + 1280 + c8 * 8, 1408, f);
#pragma unroll
    for (int j = 0; j < 8; ++j) f[j] = sigmoidf_(f[j]);
    *(uint4*)(Ag + row * 128 + c8 * 8) = pack8(f);
  }
  const float* rk = p.in[I_RWRK] + li * 384;
  for (int it = 0; it < 12; ++it) {
    const int rh = it / 6, h = it % 6;
    const int row = rh * 8 + (lane >> 3), c8 = lane & 7;
    const int tok = tok0 + row; bool hp, hn; tok_nb(tok, hp, hn);
    const int col = h * 64 + c8 * 8;
    float r8[8], k8[8], v8[8];
    conv8(Prw, 1408, tok, hp, hn, col, cw + col, 1408, r8);
    conv8(Prw, 1408, tok, hp, hn, 384 + col, cw + 384 + col, 1408, k8);
    conv8(Prw, 1408, tok, hp, hn, 768 + col, cw + 768 + col, 1408, v8);
    float s = 0.f;
#pragma unroll
    for (int j = 0; j < 8; ++j) s += r8[j] * k8[j] * rk[col + j];
    s = sum8(s);
#pragma unroll
    for (int j = 0; j < 8; ++j) v8[j] *= s;
    *(uint4*)(BV + row * 384 + col) = pack8(v8);
  }
  __builtin_amdgcn_fence(__ATOMIC_RELEASE, "wavefront");
  __builtin_amdgcn_wave_barrier();
  __builtin_amdgcn_fence(__ATOMIC_ACQUIRE, "wavefront");
  const int c = lane & 15, quad = lane >> 4;
  bf16x8 af[4];
#pragma unroll
  for (int ks = 0; ks < 4; ++ks) af[ks] = *(const bf16x8*)(Ag + c * 128 + ks * 32 + quad * 8);
  const u16* W = (const u16*)(p.ws + OFF_GUT) + (size_t)li * 384 * 128;
  u16* G = (u16*)(p.ws + OFF_G);
  u16* BG = (u16*)(p.ws + OFF_BG);
  for (int h = 0; h < 6; ++h) {
    f32x4 acc[4];
#pragma unroll
    for (int j = 0; j < 4; ++j) acc[j] = (f32x4){0.f, 0.f, 0.f, 0.f};
#pragma unroll
    for (int ks = 0; ks < 4; ++ks)
#pragma unroll
      for (int j = 0; j < 4; ++j) {
        bf16x8 bb = *(const bf16x8*)(W + (size_t)(h * 64 + j * 16 + c) * 128 + ks * 32 + quad * 8);
        acc[j] = mfma16(af[ks], bb, acc[j]);
      }
#pragma unroll
    for (int j = 0; j < 4; ++j)
#pragma unroll
      for (int r = 0; r < 4; ++r) {
        const int rowi = quad * 4 + r, col = h * 64 + j * 16 + c;
        const float g = acc[j][r];
        G[(size_t)(tok0 + rowi) * 384 + col] = f2bf(g);
        BG[(size_t)(tok0 + rowi) * 384 + col] = f2bf(g * bf2f(BV[rowi * 384 + col]));
      }
  }
  __builtin_amdgcn_wave_barrier();
}

DEV void filt_item(const Params& p, int li, int sel, int o, int c, unsigned char* lds, const float2* TWs) {
  const int tid = opaque_tid();
  const int L = sel ? 256 : 4096, logn = sel ? 9 : 13, N2 = 2 * L;
  float2* buf = (float2*)lds;
  const int col0 = o * 512 + c, col1 = col0 + 256;
  __syncthreads();
  const float* w3a = p.in[I_HYW3] + (size_t)li * 64 * 1024 + col0;
  const float* w3b = w3a + 256;
  const float b30 = p.in[I_HYB3][li * 1024 + col0], b31 = p.in[I_HYB3][li * 1024 + col1];
  const float rate = 3.0701134573253946f + (15.350567286626972f - 3.0701134573253946f) * (float)c * (1.f / 255.f);
  const float* H2 = (const float*)(p.ws + OFF_H2) + ((size_t)li * 4352 + (sel ? 4096 : 0)) * 64;
  float ss = 0.f;
#pragma unroll 1
  for (int dd = 0; dd < 2; ++dd) {
    const float* w3 = dd ? w3b : w3a;
    const float b3v = dd ? b31 : b30;
    for (int t = tid; t < L; t += 256) {
      const float4* hr = (const float4*)(H2 + (size_t)t * 64);
      float d0 = b3v;
#pragma unroll
      for (int i = 0; i < 16; ++i) {
        float4 h = hr[i];
        d0 += h.x * w3[(i * 4) * 1024] + h.y * w3[(i * 4 + 1) * 1024] + h.z * w3[(i * 4 + 2) * 1024] + h.w * w3[(i * 4 + 3) * 1024];
      }
      const float v0 = d0 * __expf(-((float)t / (float)L) * rate);
      if (dd == 0) { buf[t] = make_float2(v0, 0.f); ss += v0 * v0; }
      else if (t >= 1) { buf[N2 - t] = make_float2(v0, 0.f); ss += v0 * v0; }
    }
  }
  ss = wave_sum(ss);
  float tot = 0.f;
  if ((tid & 63) == 0 && tid < 128) ((float*)&buf[L])[tid >> 6] = ss;
  __syncthreads();
  tot += buf[L].x + buf[L].y;
  __syncthreads();
  if ((tid & 63) == 0 && tid >= 128) ((float*)&buf[L])[(tid >> 6) - 2] = ss;
  __syncthreads();
  tot += buf[L].x + buf[L].y;
  __syncthreads();
  if (tid == 0) buf[L] = make_float2(0.f, 0.f);
  __syncthreads();
  const float scale = rsqrtf(tot) / (float)N2;
  fft_fwd(buf, logn, TWs);
  float2* HF = (float2*)(p.ws + OFF_HF) + (sel ? (size_t)2 * 256 * 8192 : 0) + (size_t)(o * 256 + c) * N2;
  for (int i = tid; i < N2; i += 256) { float2 v = buf[i]; HF[i] = make_float2(v.x * scale, v.y * scale); }
}

DEV void phaseA(const Params& p, int li, unsigned char* lds) {
  const u16* XN = (const u16*)(p.ws + OFF_XN);
  const u16* Wt = (const u16*)(p.ws + OFF_WIN) + (size_t)li * 2688 * 1024;
  u16* Prw = (u16*)(p.ws + OFF_PRW);
  u16* Pmh = (u16*)(p.ws + OFF_PMH);
  const int n_filt = (li == 0) ? 1024 : 512;
  const float2* TWs = stage_tw(p, lds);
  for (int item0 = blockIdx.x; item0 < 136 * 21 + n_filt; item0 += gridDim.x) {
    if (item0 < n_filt) { const int sel = item0 >> 9, r = item0 & 511; filt_item(p, li, sel, r >> 8, r & 255, lds, TWs); continue; }
    const int item = item0 - n_filt;
    const int m0 = (item / 21) * 256, n0 = (item % 21) * 128;
    gemm_tile<256, 128, 2, 2>(lds, 1024,
      [&](int row, int k) { return *(const uint4*)(XN + (size_t)(m0 + row) * 1024 + k); },
      [&](int row, int k) { return *(const uint4*)(Wt + (size_t)(n0 + row) * 1024 + k); },
      [&](int mrow, int ncol, f32x4 a) {
        const int n = n0 + ncol;
        if (n < 2592) {
#pragma unroll
          for (int r = 0; r < 4; ++r) {
            const int tok = m0 + mrow + r;
            if (n < 1408) Prw[(size_t)tok * 1408 + n] = f2bf(a[r]);
            else Pmh[(size_t)tok * 1184 + (n - 1408)] = f2bf(a[r]);
          }
        }
      });
  }
}


DEV void phaseB(const Params& p, int li, unsigned char* lds) {
  const bool need_ctx = (li == 0);
  const int n_mla = 544;
  const int n_hytt = need_ctx ? 544 : 512, n_hy = n_hytt * 3;
  const int n_rwg = need_ctx ? 544 : 512;
  const int total = n_mla + n_hy + n_rwg;
  for (int item = blockIdx.x; item < total; item += gridDim.x) {
    int r = item;
    if (r < n_mla) { mla_item(p, li, r, lds); continue; } r -= n_mla;
    if (r < n_hy) { hy_item(p, li, r / n_hytt, r % n_hytt, lds); continue; } r -= n_hy;
    rwg_item(p, li, r, lds);
  }
}

DEV void scan_item(const Params& p, int li, int item, unsigned char* lds) {
  const int tid = opaque_tid(), lane = tid & 63, wave = tid >> 6;
  const int dir = item & 1, bh = item >> 1, b = bh / 6, h = bh % 6;
  float* STEP = (float*)lds;
  u16* DL = (u16*)(lds + 49152);
  u16* AL = DL + 32 * 72;
  u16* YS = (u16*)(lds + 49152 + 2 * 32 * 72 * 2);
  const u16* Prw = (const u16*)(p.ws + OFF_PRW);
  const float* cw = p.in[I_RWCONV] + (size_t)li * 3 * 1408;
  const float* kkw = p.in[I_RWKK] + li * 384 + h * 64;
  const float* kaw = p.in[I_RWKA] + li * 384 + h * 64;
  const float* d0 = p.in[I_RWD0] + (size_t)(li * 2 + dir) * 384 + h * 64;
  const float* a0 = p.in[I_RWA0] + (size_t)(li * 2 + dir) * 384 + h * 64;
  const u16* DUT = (const u16*)(p.ws + OFF_DUT) + ((size_t)(li * 2 + dir) * 384 + h * 64) * 64;
  const u16* AUT = (const u16*)(p.ws + OFF_AUT) + ((size_t)(li * 2 + dir) * 384 + h * 64) * 64;
  u16* Yd = (u16*)(p.ws + (dir ? OFF_Y1 : OFF_Y0));
  const int vrow = tid >> 2, q = tid & 3;
  f32x2 S[8];
#pragma unroll
  for (int i = 0; i < 8; ++i) S[i] = (f32x2){0.f, 0.f};
  const int c = lane & 15, quad = lane >> 4;
  __syncthreads();
  for (int ch = 0; ch < 136; ++ch) {
    int tokbase, t0, L;
    if (ch < 8) { L = 256; tokbase = TLAT + b * 256; t0 = (dir ? (7 - ch) : ch) * 32; }
    else { L = 4096; tokbase = b * 4096; const int cc = ch - 8; t0 = (dir ? (127 - cc) : cc) * 32; }
#pragma unroll
    for (int i = 0; i < 5; ++i) {
      const int id = tid + 256 * i;
      const int c8 = id & 7, part = (id >> 3) % 5, tl = id / 40;
      const int t = t0 + tl, tok = tokbase + t;
      const int col = (part < 3) ? (part * 384 + h * 64 + c8 * 8) : (1152 + (part - 3) * 64 + c8 * 8);
      float f[8];
      conv8(Prw, 1408, tok, t > 0, t < L - 1, col, cw + col, 1408, f);
      float ssk = 0.f;
      float kr[8];
#pragma unroll
      for (int j = 0; j < 8; ++j) { kr[j] = f[j] * kkw[c8 * 8 + j]; ssk += kr[j] * kr[j]; }
      ssk = sum8(ssk);
      float* sp = STEP + tl * 384;
      if (part == 0) { *(float4*)(sp + 256 + c8 * 8) = make_float4(f[0], f[1], f[2], f[3]); *(float4*)(sp + 256 + c8 * 8 + 4) = make_float4(f[4], f[5], f[6], f[7]); }
      else if (part == 1) {
        *(float4*)(sp + 192 + c8 * 8) = make_float4(f[0], f[1], f[2], f[3]); *(float4*)(sp + 192 + c8 * 8 + 4) = make_float4(f[4], f[5], f[6], f[7]);
        const float rs = rsqrtf(ssk + 1e-12f);
        *(float4*)(sp + c8 * 8) = make_float4(kr[0] * rs, kr[1] * rs, kr[2] * rs, kr[3] * rs);
        *(float4*)(sp + c8 * 8 + 4) = make_float4(kr[4] * rs, kr[5] * rs, kr[6] * rs, kr[7] * rs);
      }
      else if (part == 2) { *(float4*)(sp + 320 + c8 * 8) = make_float4(f[0], f[1], f[2], f[3]); *(float4*)(sp + 320 + c8 * 8 + 4) = make_float4(f[4], f[5], f[6], f[7]); }
      else if (part == 3) {
#pragma unroll
        for (int j = 0; j < 8; ++j) f[j] = tanhf(f[j]);
        *(uint4*)(DL + tl * 72 + c8 * 8) = pack8(f);
      }
      else { *(uint4*)(AL + tl * 72 + c8 * 8) = pack8(f); }
    }
    __syncthreads();
    {
      const int mt = wave >> 1;
      bf16x8 ad[2], aa[2];
#pragma unroll
      for (int ks = 0; ks < 2; ++ks) {
        ad[ks] = *(const bf16x8*)(DL + (mt * 16 + c) * 72 + ks * 32 + quad * 8);
        aa[ks] = *(const bf16x8*)(AL + (mt * 16 + c) * 72 + ks * 32 + quad * 8);
      }
#pragma unroll
      for (int jn = 0; jn < 2; ++jn) {
        const int nt = (wave & 1) * 2 + jn;
        f32x4 accd = (f32x4){0.f, 0.f, 0.f, 0.f}, acca = accd;
#pragma unroll
        for (int ks = 0; ks < 2; ++ks) {
          bf16x8 bd = *(const bf16x8*)(DUT + (size_t)(nt * 16 + c) * 64 + ks * 32 + quad * 8);
          bf16x8 ba = *(const bf16x8*)(AUT + (size_t)(nt * 16 + c) * 64 + ks * 32 + quad * 8);
          accd = mfma16(ad[ks], bd, accd);
          acca = mfma16(aa[ks], ba, acca);
        }
        const int col = nt * 16 + c;
        const float d0c = d0[col], a0c = a0[col], kac = kaw[col];
#pragma unroll
        for (int r = 0; r < 4; ++r) {
          const int tl = mt * 16 + quad * 4 + r;
          float* sp = STEP + tl * 384;
          const float w = __expf(-0.6065306597f * sigmoidf_(d0c + accd[r]));
          const float a = sigmoidf_(a0c + acca[r]);
          const float kraw = sp[192 + col], kk = sp[col];
          sp[64 + col] = w;
          sp[128 + col] = a * kk;
          sp[192 + col] = kraw * (1.f + (a - 1.f) * kac);
        }
      }
    }
    __syncthreads();
#define SCAN_LOAD(TL, KK, W, AK, KR, RR, VV) { \
      const float* sp_ = STEP + (TL) * 384 + q * 16; \
      _Pragma("unroll") for (int i = 0; i < 4; ++i) { f32x4 t_; \
        t_ = *(const f32x4*)(sp_ + i * 4);        KK[2 * i] = t_.xy; KK[2 * i + 1] = t_.zw; \
        t_ = *(const f32x4*)(sp_ + 64 + i * 4);   W[2 * i] = t_.xy;  W[2 * i + 1] = t_.zw; \
        t_ = *(const f32x4*)(sp_ + 128 + i * 4);  AK[2 * i] = t_.xy; AK[2 * i + 1] = t_.zw; \
        t_ = *(const f32x4*)(sp_ + 192 + i * 4);  KR[2 * i] = t_.xy; KR[2 * i + 1] = t_.zw; \
        t_ = *(const f32x4*)(sp_ + 256 + i * 4);  RR[2 * i] = t_.xy; RR[2 * i + 1] = t_.zw; } \
      VV = STEP[(TL) * 384 + 320 + vrow]; }
#define SCAN_STEP(TL, KK, W, AK, KR, RR, VV) { \
      f32x2 pa = S[0] * KK[0], pb = S[1] * KK[1]; \
      _Pragma("unroll") for (int i = 2; i < 8; i += 2) { pa += S[i] * KK[i]; pb += S[i + 1] * KK[i + 1]; } \
      pa += pb; \
      float pd = sum4(pa.x + pa.y); \
      const f32x2 npd = (f32x2){-pd, -pd}, vv2 = (f32x2){VV, VV}; \
      f32x2 ya = (f32x2){0.f, 0.f}, yb = ya; \
      _Pragma("unroll") for (int i = 0; i < 8; i += 2) { \
        S[i] = S[i] * W[i] + (vv2 * KR[i] + npd * AK[i]); \
        S[i + 1] = S[i + 1] * W[i + 1] + (vv2 * KR[i + 1] + npd * AK[i + 1]); \
        ya += S[i] * RR[i]; yb += S[i + 1] * RR[i + 1]; } \
      ya += yb; \
      const float y = sum4(ya.x + ya.y); \
      if (q == 0) YS[(TL) * 64 + vrow] = f2bf(y); }
    for (int st = 0; st < 32; st += 2) {
      const int tl0 = dir ? (31 - st) : st, tl1 = dir ? (30 - st) : (st + 1);
      f32x2 kk0[8], w0[8], ak0[8], kr0[8], rr0[8], kk1[8], w1[8], ak1[8], kr1[8], rr1[8];
      float vv0, vv1;
      SCAN_LOAD(tl0, kk0, w0, ak0, kr0, rr0, vv0)
      SCAN_LOAD(tl1, kk1, w1, ak1, kr1, rr1, vv1)
      SCAN_STEP(tl0, kk0, w0, ak0, kr0, rr0, vv0)
      SCAN_STEP(tl1, kk1, w1, ak1, kr1, rr1, vv1)
    }
    __syncthreads();
    {
      const int tl = tid >> 3, c8 = tid & 7;
      *(uint4*)(Yd + (size_t)(tokbase + t0 + tl) * 384 + h * 64 + c8 * 8) = *(const uint4*)(YS + tl * 64 + c8 * 8);
    }
  }
}

DEV void attn_item(const Params& p, int b, int h, int q0, int kt0, int kt1, int tok_q0, unsigned char* lds) {
  const int tid = opaque_tid(), lane = tid & 63, wave = tid >> 6;
  const int c = lane & 15, quad = lane >> 4;
  u16* Ks = (u16*)lds;
  u16* Vs = Ks + 64 * 104;
  const size_t bh = (size_t)(b * 6 + h);
  const u16* QB = (const u16*)(p.ws + OFF_QB) + bh * KTOT * 96;
  const u16* KB = (const u16*)(p.ws + OFF_KB) + bh * KTOT * 96;
  const u16* VT = (const u16*)(p.ws + OFF_VT) + bh * 64 * KTOT;
  bf16x8 qf[4][3];
#pragma unroll
  for (int n = 0; n < 4; ++n)
#pragma unroll
    for (int ks = 0; ks < 3; ++ks) qf[n][ks] = *(const bf16x8*)(QB + (size_t)(q0 + wave * 64 + n * 16 + c) * 96 + ks * 32 + quad * 8);
  f32x4 ot[4][4];
#pragma unroll
  for (int d = 0; d < 4; ++d)
#pragma unroll
    for (int n = 0; n < 4; ++n) ot[d][n] = (f32x4){0.f, 0.f, 0.f, 0.f};
  float mrun[4] = {-1e30f, -1e30f, -1e30f, -1e30f}, lsum[4] = {0.f, 0.f, 0.f, 0.f};
  uint4 rk0, rk1, rk2, rv0, rv1;
#define ATT_KLD(KT, I) (*(const uint4*)(KB + (size_t)((KT) * 64 + (tid + 256 * (I)) / 12) * 96 + ((tid + 256 * (I)) % 12) * 8))
#define ATT_VLD(KT, I) (*(const uint4*)(VT + (size_t)((tid + 256 * (I)) >> 3) * KTOT + (KT) * 64 + ((tid + 256 * (I)) & 7) * 8))
#define ATT_GLOAD(KT) { rk0 = ATT_KLD(KT, 0); rk1 = ATT_KLD(KT, 1); rk2 = ATT_KLD(KT, 2); rv0 = ATT_VLD(KT, 0); rv1 = ATT_VLD(KT, 1); }
  ATT_GLOAD(kt0);
  for (int kt = kt0; kt < kt1; ++kt) {
    __syncthreads();
    { const int id = tid; *(uint4*)(Ks + (id / 12) * 104 + (id % 12) * 8) = rk0; }
    { const int id = tid + 256; *(uint4*)(Ks + (id / 12) * 104 + (id % 12) * 8) = rk1; }
    { const int id = tid + 512; *(uint4*)(Ks + (id / 12) * 104 + (id % 12) * 8) = rk2; }
    { const int id = tid; uint2* d = (uint2*)(Vs + (id >> 3) * 68 + (id & 7) * 8); d[0] = make_uint2(rv0.x, rv0.y); d[1] = make_uint2(rv0.z, rv0.w); }
    { const int id = tid + 256; uint2* d = (uint2*)(Vs + (id >> 3) * 68 + (id & 7) * 8); d[0] = make_uint2(rv1.x, rv1.y); d[1] = make_uint2(rv1.z, rv1.w); }
    __syncthreads();
    if (kt + 1 < kt1) ATT_GLOAD(kt + 1);
    f32x4 st[4][4];
#pragma unroll
    for (int i = 0; i < 4; ++i)
#pragma unroll
      for (int n = 0; n < 4; ++n) st[i][n] = (f32x4){0.f, 0.f, 0.f, 0.f};
#pragma unroll
    for (int ks = 0; ks < 3; ++ks)
#pragma unroll
      for (int i = 0; i < 4; ++i) {
        const bf16x8 ak = *(const bf16x8*)(Ks + (i * 16 + c) * 104 + ks * 32 + quad * 8);
#pragma unroll
        for (int n = 0; n < 4; ++n) st[i][n] = mfma16(ak, qf[n][ks], st[i][n]);
      }
    bf16x8 pb[4][2];
#pragma unroll
    for (int n = 0; n < 4; ++n) {
      float mx = st[0][n][0];
#pragma unroll
      for (int i = 0; i < 4; ++i)
#pragma unroll
        for (int r = 0; r < 4; ++r) mx = fmaxf(mx, st[i][n][r]);
      mx = fmaxf(mx, __shfl_xor(mx, 16)); mx = fmaxf(mx, __shfl_xor(mx, 32));
      const float mnew = fmaxf(mrun[n], mx);
      const float alpha = __builtin_amdgcn_exp2f(mrun[n] - mnew);
      mrun[n] = mnew;
      float ls = 0.f;
      float pv[16];
#pragma unroll
      for (int i = 0; i < 4; ++i)
#pragma unroll
        for (int r = 0; r < 4; ++r) { const float e = __builtin_amdgcn_exp2f(st[i][n][r] - mnew); pv[i * 4 + r] = e; ls += e; }
      lsum[n] = lsum[n] * alpha + ls;
      if (__builtin_amdgcn_ballot_w64(alpha != 1.0f) != 0ull) {
#pragma unroll
        for (int d = 0; d < 4; ++d) ot[d][n] *= alpha;
      }
#pragma unroll
      for (int kk = 0; kk < 2; ++kk) pb[n][kk] = as_bf8(pack8(pv + kk * 8));
    }
#pragma unroll
    for (int kk = 0; kk < 2; ++kk)
#pragma unroll
      for (int d = 0; d < 4; ++d) {
        const uint2 lo = *(const uint2*)(Vs + (d * 16 + c) * 68 + kk * 32 + quad * 4);
        const uint2 hi = *(const uint2*)(Vs + (d * 16 + c) * 68 + kk * 32 + 16 + quad * 4);
        const bf16x8 av = as_bf8(make_uint4(lo.x, lo.y, hi.x, hi.y));
#pragma unroll
        for (int n = 0; n < 4; ++n) ot[d][n] = mfma16(av, pb[n][kk], ot[d][n]);
      }
  }
  u16* ATT = (u16*)(p.ws + OFF_ATT);
#pragma unroll
  for (int n = 0; n < 4; ++n) {
    float l = lsum[n];
    l += __shfl_xor(l, 16); l += __shfl_xor(l, 32);
    const float inv = 1.f / l;
    const int tok = tok_q0 + wave * 64 + n * 16 + c;
#pragma unroll
    for (int d = 0; d < 4; ++d) {
      uint2 o;
      o.x = pack2(ot[d][n][0] * inv, ot[d][n][1] * inv);
      o.y = pack2(ot[d][n][2] * inv, ot[d][n][3] * inv);
      *(uint2*)(ATT + (size_t)tok * 384 + h * 64 + d * 16 + quad * 4) = o;
    }
  }
}

template <int NJ>
DEV void hyfft_item(const Params& p, int li, int c, int bp, unsigned char* lds, const float2* TW) {
  constexpr int L = NJ * 256, N2 = 2 * L, logn = (NJ == 16) ? 13 : 9;
  const int tid = opaque_tid();
  float2* buf = (float2*)lds;
  const size_t seqoff = (NJ == 16) ? 0 : (size_t)8 * 256 * 4096;
  const size_t o0 = seqoff + ((size_t)(2 * bp) * 256 + c) * L, o1 = seqoff + ((size_t)(2 * bp + 1) * 256 + c) * L;
  const u16* HG0 = (const u16*)(p.ws + OFF_HYIN);
  const u16* HG1 = HG0 + (size_t)TT * 256;
  const u16* HU = HG1 + (size_t)TT * 256;
  u16* HO = (u16*)(p.ws + OFF_HYO);
  const float2* HF = (const float2*)(p.ws + OFF_HF) + ((NJ == 16) ? 0 : (size_t)2 * 256 * 8192);
  float2 yr[NJ];
  __syncthreads();
#pragma unroll
  for (int j = 0; j < NJ; ++j) {
    const int t = tid + 256 * j;
    yr[j] = make_float2(bf2f(HU[o0 + t]), bf2f(HU[o1 + t]));
    buf[t] = yr[j];
    buf[L + t] = make_float2(0.f, 0.f);
  }
  __syncthreads();
#pragma unroll 1
  for (int o = 0; o < 2; ++o) {
    fft_fwd(buf, logn, TW);
    const float2* hf = HF + (size_t)(o * 256 + c) * N2;
    for (int i = tid; i < N2; i += 256) buf[i] = cmul(buf[i], hf[i]);
    __syncthreads();
    fft_inv(buf, logn, TW);
    const float bias = p.in[I_HYBIAS][(li * 2 + o) * 256 + c];
    const u16* HG = o ? HG1 : HG0;
#pragma unroll
    for (int j = 0; j < NJ; ++j) {
      const int t = tid + 256 * j;
      const float2 v = buf[t];
      yr[j].x = bf2f(HG[o0 + t]) * (v.x + yr[j].x * bias);
      yr[j].y = bf2f(HG[o1 + t]) * (v.y + yr[j].y * bias);
    }
    __syncthreads();
    if (o == 0) {
#pragma unroll
      for (int j = 0; j < NJ; ++j) { const int t = tid + 256 * j; buf[t] = yr[j]; buf[L + t] = make_float2(0.f, 0.f); }
      __syncthreads();
    } else {
#pragma unroll
      for (int j = 0; j < NJ; ++j) { const int t = tid + 256 * j; HO[o0 + t] = f2bf(yr[j].x); HO[o1 + t] = f2bf(yr[j].y); }
    }
  }
}

DEV void phaseC(const Params& p, int li, unsigned char* lds, int cidx = -1, int only = 0) {
  const bool need_ctx = (li == 0);
  const int n_scan = (only == 0 || only == 1) ? 96 : 0, n_attn = (only == 0 || only == 2) ? 768 : 0, n_fft = (only == 0 || only == 3) ? 1024 : 0, n_attc = (need_ctx && only == 0) ? 48 : 0, n_fftc = (need_ctx && only == 0) ? 1024 : 0;
  const int total = n_scan + n_attn + n_fft + n_attc + n_fftc;
  const float2* TWs = stage_tw(p, lds);
  unsigned* ctr = (unsigned*)(p.ws + OFF_CTR) + (cidx < 0 ? li : cidx);
  int* sitem = (int*)(lds + LDS_BYTES - 16);
  for (;;) {
    __syncthreads();
    if (threadIdx.x == 0) *sitem = (int)atomicAdd(ctr, 1u);
    __syncthreads();
    int r = *sitem;
    if (r >= total) break;
    if (r < n_scan) { scan_item(p, li, r, lds); continue; } r -= n_scan;
    if (r < n_attn) { const int bh = r >> 4, qt = r & 15; const int b = bh / 6, h = bh % 6; attn_item(p, b, h, qt * 256, 0, 68, b * 4096 + qt * 256, lds); continue; } r -= n_attn;
    if (r < n_fft) { hyfft_item<16>(p, li, r >> 2, r & 3, lds, TWs); continue; } r -= n_fft;
    if (r < n_attc) { const int bh = r; const int b = bh / 6, h = bh % 6; attn_item(p, b, h, 4096, 64, 68, TLAT + b * 256, lds); continue; } r -= n_attc;
    hyfft_item<1>(p, li, r >> 2, r & 3, lds, TWs);
  }
}

constexpr size_t OFF_MIX = OFF_QB;
DEV void phaseD0(const Params& p, int li) {
  const int tid = opaque_tid();
  const int ntok = (li == 0) ? TT : TLAT;
  const u16* Y0 = (const u16*)(p.ws + OFF_Y0);
  const u16* Y1 = (const u16*)(p.ws + OFF_Y1);
  const u16* G = (const u16*)(p.ws + OFF_G);
  const u16* BG = (const u16*)(p.ws + OFF_BG);
  const u16* ATT = (const u16*)(p.ws + OFF_ATT);
  const u16* HO = (const u16*)(p.ws + OFF_HYO);
  u16* MIX = (u16*)(p.ws + OFF_MIX);
  const float* gng = p.in[I_RWGNG] + li * 384;
  const float* gnb = p.in[I_RWGNB] + li * 384;
  for (int item = blockIdx.x; item < ntok / 32; item += gridDim.x) {
    const int tok = item * 32 + (tid >> 3), c8 = tid & 7;
#pragma unroll 2
    for (int kg = 0; kg < 16; ++kg) {
      const int k = kg * 64 + c8 * 8;
      uint4 o;
      if (kg < 6) {
        float a[8], bb[8], y[8];
        unpack8(*(const uint4*)(Y0 + (size_t)tok * 384 + k), a);
        unpack8(*(const uint4*)(Y1 + (size_t)tok * 384 + k), bb);
        float sm = 0.f;
#pragma unroll
        for (int j = 0; j < 8; ++j) { y[j] = a[j] + bb[j]; sm += y[j]; }
        sm = sum8(sm);
        const float mu = sm * (1.f / 64.f);
        float v = 0.f;
#pragma unroll
        for (int j = 0; j < 8; ++j) { y[j] -= mu; v += y[j] * y[j]; }
        v = sum8(v);
        const float rstd = rsqrtf(v * (1.f / 64.f) + 64e-5f);
        float g[8], bg[8];
        unpack8(*(const uint4*)(G + (size_t)tok * 384 + k), g);
        unpack8(*(const uint4*)(BG + (size_t)tok * 384 + k), bg);
#pragma unroll
        for (int j = 0; j < 8; ++j) y[j] = (y[j] * rstd * gng[k + j] + gnb[k + j]) * g[j] + bg[j];
        o = pack8(y);
      } else if (kg < 12) {
        o = *(const uint4*)(ATT + (size_t)tok * 384 + (k - 384));
      } else {
        const int ch = k - 768;
        const u16* src; int L;
        if (tok < TLAT) { L = 4096; src = HO + ((size_t)(tok >> 12) * 256 + ch) * 4096 + (tok & 4095); }
        else { L = 256; const int u = tok - TLAT; src = HO + (size_t)8 * 256 * 4096 + ((size_t)(u >> 8) * 256 + ch) * 256 + (u & 255); }
        o.x = (unsigned)src[0] | ((unsigned)src[(size_t)L] << 16);
        o.y = (unsigned)src[(size_t)2 * L] | ((unsigned)src[(size_t)3 * L] << 16);
        o.z = (unsigned)src[(size_t)4 * L] | ((unsigned)src[(size_t)5 * L] << 16);
        o.w = (unsigned)src[(size_t)6 * L] | ((unsigned)src[(size_t)7 * L] << 16);
      }
      *(uint4*)(MIX + (size_t)tok * 1024 + k) = o;
    }
  }
}
DEV void phaseD1(const Params& p, int li, unsigned char* lds) {
  const bool orig = (li == 0);
  const int nmt = (li == 0) ? 272 : 256;
  const u16* Wt = (const u16*)(p.ws + OFF_WOUT) + (size_t)li * 1024 * 1024;
  const u16* MIX = (const u16*)(p.ws + OFF_MIX);
  for (int item = blockIdx.x; item < nmt * 8; item += gridDim.x) {
    const int m0 = (item >> 3) * 128, n0 = (item & 7) * 128;
    gemm_tile<128, 128, 2, 2>(lds, 1024,
      [&](int row, int k) { return *(const uint4*)(MIX + (size_t)(m0 + row) * 1024 + k); },
      [&](int row, int k) { return *(const uint4*)(Wt + (size_t)(n0 + row) * 1024 + k); },
      [&](int mrow, int ncol, f32x4 a) {
        const int n = n0 + ncol;
#pragma unroll
        for (int r = 0; r < 4; ++r) {
          const int tok = m0 + mrow + r;
          const float gm = modp(p, li, tok_mv(tok), 2)[n];
          xdst(p, tok)[n] = xsrc(p, tok, orig)[n] + gm * a[r];
        }
      });
  }
}

constexpr size_t OFF_PUB = OFF_PRW;
typedef float f32x2v __attribute__((ext_vector_type(2)));
DEV unsigned pack_fp8x4(float a, float b, float c, float d) {
  int p = __builtin_amdgcn_cvt_pk_fp8_f32(a, b, 0, false);
  p = __builtin_amdgcn_cvt_pk_fp8_f32(c, d, p, true);
  return (unsigned)p;
}
DEV void unpack_fp8x4(unsigned v, float* f) {
  const f32x2v lo = __builtin_amdgcn_cvt_pk_f32_fp8((int)v, false), hi = __builtin_amdgcn_cvt_pk_f32_fp8((int)v, true);
  f[0] = lo.x; f[1] = lo.y; f[2] = hi.x; f[3] = hi.y;
}
constexpr float PEER_USCALE = 64.f, PEER_VSCALE = 4.f;
DEV void cvt_peer(const Params& p, int li) {
  const int tid = opaque_tid();
  const float* PU = p.in[I_PU] + (size_t)li * 16384 * 1024;
  const float* PV = p.in[I_PV] + (size_t)li * 16384 * 1024;
  unsigned char* dst = p.ws + OFF_PUB;
#pragma unroll 4
  for (int item = blockIdx.x; item < 16384; item += gridDim.x) {
    const bool isu = item < 8192;
    const float* src = isu ? PU + (size_t)item * 2048 : PV + (size_t)(item - 8192) * 2048;
    const float sc = isu ? PEER_USCALE : PEER_VSCALE;
    const float4 a = *(const float4*)(src + tid * 8), b = *(const float4*)(src + tid * 8 + 4);
    uint2 o;
    o.x = pack_fp8x4(a.x * sc, a.y * sc, a.z * sc, a.w * sc);
    o.y = pack_fp8x4(b.x * sc, b.y * sc, b.z * sc, b.w * sc);
    *(uint2*)(dst + (size_t)item * 2048 + tid * 8) = o;
  }
}

DEV bool better(float v, int i, float ov, int oi) { return v > ov || (v == ov && i < oi); }
#define ARGMAX16_STEP(V, I, CTRL) { const float ov_ = dppf<CTRL>(V); const int oi_ = dppi<CTRL>(I); if (better(ov_, oi_, V, I)) { V = ov_; I = oi_; } }
#define ARGMAX16(V, I) ARGMAX16_STEP(V, I, 0x128) ARGMAX16_STEP(V, I, 0x124) ARGMAX16_STEP(V, I, 0x122) ARGMAX16_STEP(V, I, 0x121)
DEV void phaseD3(const Params& p, int li, unsigned char* lds) {
  const int nmt = (li == 0) ? 272 : 256;
  const u16* XN = (const u16*)(p.ws + OFF_XN);
  const int tid = opaque_tid(), lane = tid & 63, wave = tid >> 6;
  const int c = lane & 15, quad = lane >> 4, base = lane & 48;
  u16* Qs = (u16*)lds;
  u16* KS = (u16*)(lds + 67584);
  const float NEG = -3.0e38f;
  for (int item = blockIdx.x; item < nmt * 8; item += gridDim.x) {
    const int m0 = (item >> 3) * 128, h = item & 7;
    const u16* Wt = (const u16*)(p.ws + OFF_WQ) + ((size_t)li * 2048 + h * 256) * 1024;
    gemm_tile<128, 256, 1, 4>(lds, 1024,
      [&](int row, int k) { return *(const uint4*)(XN + (size_t)(m0 + row) * 1024 + k); },
      [&](int row, int k) { return *(const uint4*)(Wt + (size_t)row * 1024 + k); },
      [&](int mrow, int ncol, f32x4 a) {
#pragma unroll
        for (int r = 0; r < 4; ++r) Qs[(mrow + r) * 264 + ncol] = f2bf(a[r]);
      });
    float sv[2][2][4]; int si[2][2][4];
#pragma unroll
    for (int pp = 0; pp < 2; ++pp) {
      const u16* keys = (const u16*)(p.ws + OFF_KEYS) + ((size_t)((li * 8 + h) * 2 + pp) * 128) * 128;
      f32x4 s[2][8];
#pragma unroll
      for (int mt = 0; mt < 2; ++mt)
#pragma unroll
        for (int j = 0; j < 8; ++j) s[mt][j] = (f32x4){0.f, 0.f, 0.f, 0.f};
#pragma unroll
      for (int hf = 0; hf < 2; ++hf) {
        __syncthreads();
#pragma unroll
        for (int i = 0; i < 4; ++i) { const int id = tid + 256 * i; *(uint4*)(KS + (id >> 4) * 136 + (id & 15) * 8) = *(const uint4*)(keys + (size_t)(hf * 64 + (id >> 4)) * 128 + (id & 15) * 8); }
        __syncthreads();
#pragma unroll
        for (int ks = 0; ks < 4; ++ks) {
          bf16x8 kb[4];
#pragma unroll
          for (int j = 0; j < 4; ++j) kb[j] = *(const bf16x8*)(KS + (j * 16 + c) * 136 + ks * 32 + quad * 8);
#pragma unroll
          for (int mt = 0; mt < 2; ++mt) {
            const bf16x8 af = *(const bf16x8*)(Qs + (wave * 32 + mt * 16 + c) * 264 + pp * 128 + ks * 32 + quad * 8);
#pragma unroll
            for (int j = 0; j < 4; ++j) s[mt][hf * 4 + j] = mfma16(af, kb[j], s[mt][hf * 4 + j]);
          }
        }
      }
#pragma unroll 1
      for (int k = 0; k < 16; ++k) {
#pragma unroll
        for (int mt = 0; mt < 2; ++mt)
#pragma unroll
          for (int r = 0; r < 4; ++r) {
            float bv = s[mt][0][r]; int bi = c;
#pragma unroll
            for (int j = 1; j < 8; ++j) if (s[mt][j][r] > bv) { bv = s[mt][j][r]; bi = j * 16 + c; }
            ARGMAX16(bv, bi)
            if (c == k) { sv[mt][pp][r] = bv; si[mt][pp][r] = bi; }
#pragma unroll
            for (int j = 0; j < 8; ++j) if (bi == j * 16 + c) s[mt][j][r] = NEG;
          }
      }
    }
    int* EIDX = (int*)(p.ws + OFF_EIDX);
    float* GATE = (float*)(p.ws + OFF_GATE);
#pragma unroll
    for (int mt = 0; mt < 2; ++mt) {
      float cv[4][16];
#pragma unroll
      for (int r = 0; r < 4; ++r)
#pragma unroll
        for (int i = 0; i < 16; ++i) {
          const float a = __shfl(sv[mt][0][r], base + i);
          cv[r][i] = ((i + 1) * (c + 1) <= 16) ? (a + sv[mt][1][r]) : NEG;
        }
      float tv[4]; int te[4];
#pragma unroll
      for (int r = 0; r < 4; ++r) { tv[r] = 0.f; te[r] = 0; }
#pragma unroll 1
      for (int k = 0; k < 16; ++k) {
#pragma unroll
        for (int r = 0; r < 4; ++r) {
          float bv = cv[r][0]; int bf = c;
#pragma unroll
          for (int i = 1; i < 16; ++i) if (cv[r][i] > bv) { bv = cv[r][i]; bf = i * 16 + c; }
          ARGMAX16(bv, bf)
          const int wi = bf >> 4, wj = bf & 15;
          const int e0 = __shfl(si[mt][0][r], base + wi), e1 = __shfl(si[mt][1][r], base + wj);
          if (c == k) { tv[r] = bv; te[r] = e0 * 128 + e1; }
#pragma unroll
          for (int i = 0; i < 16; ++i) if (wj == c && wi == i) cv[r][i] = NEG;
        }
      }
#pragma unroll
      for (int r = 0; r < 4; ++r) {
        const float mx = __shfl(tv[r], base);
        const float e = __expf(tv[r] - mx);
        const float sum = sum16(e);
        const int tok = m0 + wave * 32 + mt * 16 + quad * 4 + r;
        EIDX[(size_t)tok * 128 + h * 16 + c] = te[r];
        GATE[(size_t)tok * 128 + h * 16 + c] = e / sum;
      }
    }
  }
}

template <bool DRY>
DEV void phaseD4(const Params& p, int li, unsigned char* lds) {
  const int ntok = (li == 0) ? TT : TLAT;
  const int tid_ = opaque_tid(); const int lane = tid_ & 63, wave = tid_ >> 6;
  const unsigned char* PUb = p.ws + OFF_PUB;
  const unsigned char* PVb = PUb + (size_t)16384 * 1024;
  u16* XN = (u16*)(p.ws + OFF_XN);
  for (int item = blockIdx.x; item < ntok / 4; item += gridDim.x) {
    const int tok = item * 4 + wave;
    f32x2 hv2[8];
    {
      const uint4 h0 = *(const uint4*)(XN + (size_t)tok * 1024 + lane * 16), h1 = *(const uint4*)(XN + (size_t)tok * 1024 + lane * 16 + 8);
      float hv[16];
      unpack8(h0, hv); unpack8(h1, hv + 8);
#pragma unroll
      for (int j = 0; j < 8; ++j) hv2[j] = (f32x2){hv[2 * j], hv[2 * j + 1]};
    }
    const int* EI = (const int*)(p.ws + OFF_EIDX) + (size_t)tok * 128;
    const float* GT = (const float*)(p.ws + OFF_GATE) + (size_t)tok * 128;
    const int ei0 = EI[lane], ei1 = EI[64 + lane];
    const float g0 = GT[lane], g1 = GT[64 + lane];
    f32x2 out2[8];
#pragma unroll
    for (int j = 0; j < 8; ++j) out2[j] = (f32x2){0.f, 0.f};
    uint4 ua[8], va[8];
    int e[8]; float gg[8];
#pragma unroll
    for (int u = 0; u < 8; ++u) { e[u] = __shfl(ei0, u); gg[u] = __shfl(g0, u); }
#pragma unroll
    for (int u = 0; u < 8; ++u) { ua[u] = *(const uint4*)(PUb + (size_t)e[u] * 1024 + lane * 16); }
#pragma unroll 1
    for (int i = 0; i < 128; i += 8) {
      float dot[8];
#pragma unroll
      for (int u = 0; u < 8; ++u) { va[u] = *(const uint4*)(PVb + (size_t)e[u] * 1024 + lane * 16); }
#pragma unroll
      for (int u = 0; u < 8; ++u) {
        const unsigned uw[4] = {ua[u].x, ua[u].y, ua[u].z, ua[u].w};
        f32x2 da = (f32x2){0.f, 0.f}, db = da;
#pragma unroll
        for (int q4 = 0; q4 < 4; ++q4) {
          da += __builtin_amdgcn_cvt_pk_f32_fp8((int)uw[q4], false) * hv2[2 * q4];
          db += __builtin_amdgcn_cvt_pk_f32_fp8((int)uw[q4], true) * hv2[2 * q4 + 1];
        }
        da += db;
        dot[u] = (da.x + da.y) * (1.f / PEER_USCALE);
      }
      float gcur[8];
#pragma unroll
      for (int u = 0; u < 8; ++u) gcur[u] = gg[u];
      if (i + 8 < 128) {
#pragma unroll
        for (int u = 0; u < 8; ++u) {
          const int ii = i + 8 + u;
          e[u] = (ii < 64) ? __shfl(ei0, ii) : __shfl(ei1, ii - 64);
          gg[u] = (ii < 64) ? __shfl(g0, ii) : __shfl(g1, ii - 64);
        }
#pragma unroll
        for (int u = 0; u < 8; ++u) { ua[u] = *(const uint4*)(PUb + (size_t)e[u] * 1024 + lane * 16); }
      }
#pragma unroll
      for (int u = 0; u < 8; ++u) dot[u] = wave_sum(dot[u]);
      {
        float mine = dot[0];
#pragma unroll
        for (int u = 1; u < 8; ++u) mine = ((lane & 7) == u) ? dot[u] : mine;
        const float act = 0.5f * mine * (1.f + erff(mine * 0.70710678118654752f));
#pragma unroll
        for (int u = 0; u < 8; ++u) dot[u] = __int_as_float(__builtin_amdgcn_readlane(__float_as_int(act), u)) * gcur[u] * (1.f / PEER_VSCALE);
      }
#pragma unroll
      for (int u = 0; u < 8; ++u) {
        const unsigned vw[4] = {va[u].x, va[u].y, va[u].z, va[u].w};
        const f32x2 a2 = (f32x2){dot[u], dot[u]};
#pragma unroll
        for (int q4 = 0; q4 < 4; ++q4) {
          out2[2 * q4] += a2 * __builtin_amdgcn_cvt_pk_f32_fp8((int)vw[q4], false);
          out2[2 * q4 + 1] += a2 * __builtin_amdgcn_cvt_pk_f32_fp8((int)vw[q4], true);
        }
      }
    }
    float out[16];
#pragma unroll
    for (int j = 0; j < 8; ++j) { out[2 * j] = out2[j].x; out[2 * j + 1] = out2[j].y; }
    const int mv = tok_mv(tok);
    const float* gf = modp(p, li, mv, 5) + lane * 16;
    float* xr = xdst(p, tok) + lane * 16;
    float xv[16]; float ss = 0.f;
#pragma unroll
    for (int j = 0; j < 4; ++j) {
      float4 x = *(const float4*)(xr + j * 4);
      const float4 g = *(const float4*)(gf + j * 4);
      x.x += g.x * out[j * 4]; x.y += g.y * out[j * 4 + 1]; x.z += g.z * out[j * 4 + 2]; x.w += g.w * out[j * 4 + 3];
      if (!DRY) *(float4*)(xr + j * 4) = x;
      xv[j * 4] = x.x; xv[j * 4 + 1] = x.y; xv[j * 4 + 2] = x.z; xv[j * 4 + 3] = x.w;
      ss += x.x * x.x + x.y * x.y + x.z * x.z + x.w * x.w;
    }
    if (DRY) { if (lane == 0) ((float*)(p.ws + OFF_G))[tok] = ss; }
    else if (li == 0) {
      ss = wave_sum(ss);
      const float rstd = rsqrtf(ss * (1.f / 1024.f) + 1e-6f);
      const float* gain = p.in[I_MIXNORM] + 1024 + lane * 16;
      const float* sc = modp(p, 1, mv, 1) + lane * 16;
      const float* sh = modp(p, 1, mv, 0) + lane * 16;
      float o[16];
#pragma unroll
      for (int j = 0; j < 16; ++j) o[j] = xv[j] * rstd * gain[j] * (1.f + sc[j]) + sh[j];
      *(uint4*)(XN + (size_t)tok * 1024 + lane * 16) = pack8(o);
      *(uint4*)(XN + (size_t)tok * 1024 + lane * 16 + 8) = pack8(o + 8);
    }
  }
}

DEV void dump_bf(const Params& p, size_t o0, size_t n0, size_t o1, size_t n1, size_t o2, size_t n2, size_t o3, size_t n3) {
  const size_t Q = 8388608;
  for (size_t i = (size_t)blockIdx.x * 256 + threadIdx.x; i < 4 * Q; i += (size_t)gridDim.x * 256) {
    const int q = (int)(i / Q); const size_t j = i % Q;
    const size_t off = q == 0 ? o0 : q == 1 ? o1 : q == 2 ? o2 : o3;
    const size_t n = q == 0 ? n0 : q == 1 ? n1 : q == 2 ? n2 : n3;
    const size_t stride = (DIAG == 15) ? (n / Q > 2 ? n / Q : 2) : (n / Q > 0 ? n / Q : 1);
    const size_t idx = j * stride;
    p.out[i] = idx < n ? bf2f(((const u16*)(p.ws + off))[idx]) : 0.f;
  }
}
DEV void grid_barrier(const Params& p, int k) {
  asm volatile("s_waitcnt vmcnt(0)" ::: "memory");
  if (k == 0 || (gridDim.x & 7) != 0) {
    cg::this_grid().sync();
  } else {
    __syncthreads();
    if (threadIdx.x == 0) {
      unsigned* bar = (unsigned*)(p.ws + OFF_BAR);
      const unsigned gsz = gridDim.x >> 3, g = blockIdx.x & 7;
      __builtin_amdgcn_fence(__ATOMIC_RELEASE, "agent");
      const unsigned old = __hip_atomic_fetch_add(bar + g * 64, 1u, __ATOMIC_RELAXED, __HIP_MEMORY_SCOPE_AGENT);
      if (old == (unsigned)k * gsz - 1u) __hip_atomic_fetch_add(bar + 8 * 64, 1u, __ATOMIC_RELAXED, __HIP_MEMORY_SCOPE_AGENT);
      while (__hip_atomic_load(bar + 8 * 64, __ATOMIC_RELAXED, __HIP_MEMORY_SCOPE_AGENT) < (unsigned)k * 8u) __builtin_amdgcn_s_sleep(1);
    }
    __syncthreads();
  }
  __builtin_amdgcn_fence(__ATOMIC_ACQUIRE, "agent");
}
#define PH(K, CALL) if (ph_lo <= (K) && (K) < ph_hi) { CALL; if ((K) + 1 < ph_hi) grid_barrier(p, bar_k++); }
__global__ void __launch_bounds__(256, 1) mega(Params p, int ph_lo, int ph_hi) {
  __shared__ __attribute__((aligned(16))) unsigned char lds[LDS_BYTES];
  int bar_k = 0;
#if DIAG == 9
  { uint4* q = (uint4*)(p.ws + OFF_XCTX); const size_t n = (WS_END - OFF_XCTX) / 16;
    for (size_t i = (size_t)blockIdx.x * 256 + threadIdx.x; i < n; i += (size_t)gridDim.x * 256) q[i] = make_uint4(0xAAAAAAAAu, 0xAAAAAAAAu, 0xAAAAAAAAu, 0xAAAAAAAAu);
    cg::this_grid().sync(); }
#endif
  PH(0, phase0a(p, lds))
  PH(1, norm_pass(p, 0, true, p.in[I_MIXNORM], 1, 0, TT))
#if PROBE_AB == 1
  PH(2, (phaseA(p, 0, lds), phaseA(p, 0, lds)))
#else
  PH(2, phaseA(p, 0, lds))
#endif
#if PROBE_AB == 2
  PH(3, (phaseB(p, 0, lds), phaseB(p, 0, lds)))
#else
  PH(3, phaseB(p, 0, lds))
#endif
#if DIAG == 1
  PH(4, dump_bf(p, OFF_QB, 53477376ull, OFF_HYIN, 26738688ull, OFF_G, 26738688ull, OFF_PRW, 49020928ull))
#elif DIAG == 15
  PH(4, dump_bf(p, OFF_HF + 2, 17825790ull, OFF_TW + 2, 16382ull, OFF_H2 + 2, 1114110ull, OFF_ATT, 0ull))
#elif DIAG == 11
  PH(4, dump_bf(p, OFF_PRW + 2 * (49020928ull - 8388608ull), 8388608ull, OFF_PMH + 2 * (41222144ull - 8388608ull), 8388608ull, OFF_QB + 2 * (53477376ull - 8388608ull), 8388608ull, OFF_G + 2 * (26738688ull - 8388608ull), 8388608ull))
#elif DIAG == 2
  PH(4, dump_bf(p, OFF_PRW, 49020928ull, OFF_PMH, 41222144ull, OFF_XN, 35651584ull, OFF_WIN, 5505024ull))
#else
#if PROBE_C
  PH(4, (phaseC(p, 0, lds, 2, PROBE_C), phaseC(p, 0, lds)))
#else
  PH(4, phaseC(p, 0, lds))
#endif
#endif
#if DIAG == 3
  PH(5, dump_bf(p, OFF_ATT, 13369344ull, OFF_HYO, 8912896ull, OFF_Y0, 13369344ull, OFF_Y1, 13369344ull))
#elif DIAG == 12
  PH(5, dump_bf(p, OFF_ATT + 2 * 8388608ull, 4980736ull, OFF_ATT, 0ull, OFF_ATT, 0ull, OFF_ATT, 0ull))
#elif DIAG == 13
  PH(5, dump_bf(p, OFF_Y0 + 2 * 8388608ull, 4980736ull, OFF_Y1 + 2 * 8388608ull, 4980736ull, OFF_ATT, 0ull, OFF_ATT, 0ull))
#elif DIAG == 14
  PH(5, dump_bf(p, OFF_HYO, 8388608ull, OFF_HYO + 2 * 8388608ull, 524288ull, OFF_ATT, 0ull, OFF_ATT, 0ull))
#elif DIAG == 10
  PH(5, dump_bf(p, OFF_ATT + 2 * 4980736ull, 8388608ull, OFF_HYO + 2 * 524288ull, 8388608ull, OFF_Y0 + 2 * 4980736ull, 8388608ull, OFF_Y1 + 2 * 4980736ull, 8388608ull))
#else
#if PROBE_AB == 3
  PH(5, (phaseD1(p, 0, lds), phaseD1(p, 0, lds)))
#else
  PH(5, (phaseD0(p, 0), grid_barrier(p, bar_k++), phaseD1(p, 0, lds)))
#endif
#endif
  PH(6, (norm_pass(p, 0, false, p.in[I_FFNNORM], 4, 3, TT), cvt_peer(p, 0)))
#if PROBE_D3
  PH(7, (phaseD3(p, 0, lds), phaseD3(p, 0, lds)))
#else
  PH(7, phaseD3(p, 0, lds))
#endif
#if PROBE_D4
  PH(8, (phaseD4<true>(p, 0, lds), phaseD4<false>(p, 0, lds)))
#else
  PH(8, phaseD4<false>(p, 0, lds))
#endif
  PH(9, phaseA(p, 1, lds))
  PH(10, phaseB(p, 1, lds))
  PH(11, phaseC(p, 1, lds))
  PH(12, (phaseD0(p, 1), grid_barrier(p, bar_k++), phaseD1(p, 1, lds)))
  PH(13, (norm_pass(p, 1, false, p.in[I_FFNNORM] + 1024, 4, 3, TLAT), cvt_peer(p, 1)))
  PH(14, phaseD3(p, 1, lds))
  PH(15, phaseD4<false>(p, 1, lds))
}

extern "C" void kernel_launch(void* const* d_in, const int* in_sizes, int n_in, void* d_out, int out_size, void* d_ws, size_t ws_size, hipStream_t stream) {
  static int grid_blocks = 0;
  if (!grid_blocks) {
    int dev = 0, cus = 0, per_cu = 0;
    hipGetDevice(&dev);
    hipDeviceGetAttribute(&cus, hipDeviceAttributeMultiprocessorCount, dev);
    hipOccupancyMaxActiveBlocksPerMultiprocessor(&per_cu, mega, 256, 0);
    if (per_cu > GRID_BLOCKS_PER_CU) per_cu = GRID_BLOCKS_PER_CU;
    if (per_cu < 1) per_cu = 1;
    grid_blocks = cus * per_cu;
  }
  if (n_in != N_IN || ws_size < WS_NEED) { fprintf(stderr, "kernel_launch: bad inputs n_in=%d ws=%zu need %zu\n", n_in, ws_size, (size_t)WS_NEED); return; }
  Params p{};
  for (int i = 0; i < N_IN; ++i) p.in[i] = (const float*)d_in[i];
  p.out = (float*)d_out; p.ws = (unsigned char*)d_ws;
#if MULTI_LAUNCH
  for (int ph = 0; ph < NPH; ++ph) hipLaunchKernelGGL(mega, dim3(grid_blocks), dim3(256), 0, stream, p, ph, ph + 1);
#else
  int lo = 0, hi = NPH;
  void* args[] = {&p, &lo, &hi};
  hipError_t e = hipLaunchCooperativeKernel((void*)mega, dim3(grid_blocks), dim3(256), args, 0, stream);
  if (e != hipSuccess) fprintf(stderr, "cooperative launch failed: %s (grid %d)\n", hipGetErrorString(e), grid_blocks);
#endif
}
```

```cpp
#include <hip/hip_runtime.h>
#include <hip/hip_cooperative_groups.h>
#include <cstdio>
namespace cg = cooperative_groups;

#ifndef DIAG
#define DIAG 0
#endif
#ifndef PROBE_D4
#define PROBE_D4 0
#endif
#ifndef PROBE_D3
#define PROBE_D3 0
#endif
#ifndef PROBE_AB
#define PROBE_AB 0
#endif
#ifndef PROBE_C
#define PROBE_C 0
#endif
#ifndef MULTI_LAUNCH
#define MULTI_LAUNCH 0
#endif

typedef unsigned short u16;
typedef __attribute__((ext_vector_type(8))) short bf16x8;
typedef __attribute__((ext_vector_type(4))) float f32x4;
typedef __attribute__((ext_vector_type(2))) float f32x2;
#define DEV __device__ __forceinline__

constexpr int D = 1024, TLAT = 32768, TCTX = 2048, TT = 34816, KTOT = 4352;
constexpr int NPH = 16;
constexpr int LDS_BYTES = 98304 + 256;
constexpr int GRID_BLOCKS_PER_CU = 2;

enum { I_X = 0, I_C, I_CTX, I_CCTX, I_MODW, I_MODB, I_MIXNORM, I_WIN, I_WOUT, I_RWCONV, I_RWDUP, I_RWD0, I_RWAUP, I_RWA0,
       I_RWGUP, I_RWKK, I_RWKA, I_RWRK, I_RWGNG, I_RWGNB, I_MQNORM, I_MWUQ, I_MKVNORM, I_MWUKV, I_MQGAIN, I_MKGAIN,
       I_HYCONV, I_HYW1, I_HYB1, I_HYF1, I_HYW2, I_HYB2, I_HYF2, I_HYW3, I_HYB3, I_HYBIAS, I_FFNNORM, I_PWQ, I_PKEYS, I_PU, I_PV, N_IN };

struct Params { const float* in[N_IN]; float* out; unsigned char* ws; };

constexpr size_t OFF_CTR  = 0;
constexpr size_t OFF_WIN  = 256;
constexpr size_t OFF_WOUT = OFF_WIN  + 2ull * 2688 * 1024 * 2;
constexpr size_t OFF_WQ   = OFF_WOUT + 2ull * 1024 * 1024 * 2;
constexpr size_t OFF_WUQ  = OFF_WQ   + 2ull * 2048 * 1024 * 2;
constexpr size_t OFF_WUKV = OFF_WUQ  + 2ull * 576 * 256 * 2;
constexpr size_t OFF_DUT  = OFF_WUKV + 2ull * 768 * 128 * 2;
constexpr size_t OFF_AUT  = OFF_DUT  + 4ull * 384 * 64 * 2;
constexpr size_t OFF_GUT  = OFF_AUT  + 4ull * 384 * 64 * 2;
constexpr size_t OFF_KEYS = OFF_GUT  + 2ull * 384 * 128 * 2;
constexpr size_t OFF_MOD  = OFF_KEYS + 2ull * 8 * 2 * 128 * 128 * 2;
constexpr size_t OFF_H2   = OFF_MOD  + 2ull * 9 * 6144 * 4;
constexpr size_t OFF_TW   = OFF_H2   + 2ull * 4352 * 64 * 4;
constexpr size_t OFF_ROPE = OFF_TW   + 4096ull * 8;
constexpr size_t OFF_HF   = OFF_ROPE + 2ull * 4096 * 16 * 4;
constexpr size_t OFF_XCTX = OFF_HF   + 2ull * 256 * 8192 * 8 + 2ull * 256 * 512 * 8;
constexpr size_t OFF_PRW  = OFF_XCTX + 2048ull * 1024 * 4;
constexpr size_t OFF_PMH  = OFF_PRW  + (size_t)TT * 1408 * 2;
constexpr size_t OFF_ATT  = OFF_PMH;
constexpr size_t OFF_HYO  = OFF_ATT  + (size_t)TT * 384 * 2;
constexpr size_t OFF_Y0   = OFF_HYO  + (size_t)TT * 256 * 2;
constexpr size_t OFF_QB   = OFF_PMH  + (size_t)TT * 1184 * 2;
constexpr size_t OFF_KB   = OFF_QB   + 48ull * KTOT * 96 * 2;
constexpr size_t OFF_VT   = OFF_KB   + 48ull * KTOT * 96 * 2;
constexpr size_t OFF_XN   = OFF_QB;
constexpr size_t OFF_EIDX = OFF_XN   + (size_t)TT * 1024 * 2;
constexpr size_t OFF_GATE = OFF_EIDX + (size_t)TT * 128 * 4;
constexpr size_t OFF_HYIN = OFF_VT   + 48ull * 64 * KTOT * 2;
constexpr size_t OFF_G    = OFF_HYIN + 3ull * TT * 256 * 2;
constexpr size_t OFF_BG   = OFF_G    + (size_t)TT * 384 * 2;
constexpr size_t OFF_Y1   = OFF_BG   + (size_t)TT * 384 * 2;
constexpr size_t WS_END   = OFF_Y1   + (size_t)TT * 384 * 2;
static_assert(OFF_GATE + (size_t)TT * 128 * 4 <= OFF_HYIN, "alias overflow");
static_assert(OFF_Y0 + (size_t)TT * 384 * 2 <= OFF_QB, "alias overflow 2");
constexpr size_t OFF_BAR = WS_END;
constexpr size_t WS_NEED = WS_END + 4096;
static_assert(WS_NEED <= 536870912ull, "workspace too large");

DEV u16 f2bf(float f) { unsigned r; asm("v_cvt_pk_bf16_f32 %0, %1, %1" : "=v"(r) : "v"(f)); return (u16)(r & 0xffffu); }
DEV float bf2f(u16 h) { return __uint_as_float(((unsigned)h) << 16); }
DEV unsigned pack2(float a, float b) { unsigned r; asm("v_cvt_pk_bf16_f32 %0, %1, %2" : "=v"(r) : "v"(a), "v"(b)); return r; }
DEV float lo2f(unsigned u) { return __uint_as_float(u << 16); }
DEV float hi2f(unsigned u) { return __uint_as_float(u & 0xffff0000u); }
DEV uint4 pack8(const float* f) { uint4 r; r.x = pack2(f[0], f[1]); r.y = pack2(f[2], f[3]); r.z = pack2(f[4], f[5]); r.w = pack2(f[6], f[7]); return r; }
DEV void unpack8(uint4 v, float* f) { f[0] = lo2f(v.x); f[1] = hi2f(v.x); f[2] = lo2f(v.y); f[3] = hi2f(v.y); f[4] = lo2f(v.z); f[5] = hi2f(v.z); f[6] = lo2f(v.w); f[7] = hi2f(v.w); }
DEV float sigmoidf_(float x) { return 1.f / (1.f + __expf(-x)); }

template <int CTRL> DEV float dppf(float x) { return __int_as_float(__builtin_amdgcn_update_dpp(0, __float_as_int(x), CTRL, 0xf, 0xf, false)); }
template <int CTRL> DEV int dppi(int x) { return __builtin_amdgcn_update_dpp(0, x, CTRL, 0xf, 0xf, false); }
DEV float sum4(float v) { v += dppf<0xB1>(v); v += dppf<0x4E>(v); return v; }
DEV float sum8(float v) { v = sum4(v); v += dppf<0x141>(v); return v; }
DEV float sum16(float v) { v = sum8(v); v += dppf<0x140>(v); return v; }
DEV float wave_sum(float v) { v = sum16(v); v += __shfl_xor(v, 16); v += __shfl_xor(v, 32); return v; }
DEV bf16x8 as_bf8(uint4 v) { union { uint4 u; bf16x8 b; } x; x.u = v; return x.b; }
DEV f32x4 mfma16(bf16x8 a, bf16x8 b, f32x4 c) { return __builtin_amdgcn_mfma_f32_16x16x32_bf16(a, b, c, 0, 0, 0); }
DEV float dot2bf(unsigned a, unsigned b, float c) { asm("v_dot2c_f32_bf16 %0, %1, %2" : "+v"(c) : "v"(a), "v"(b)); return c; }
DEV float fsin(float x) { return __builtin_amdgcn_sinf(x * 0.15915494309189535f); }
DEV float fcos(float x) { return __builtin_amdgcn_cosf(x * 0.15915494309189535f); }

DEV int opaque_tid() { int t = threadIdx.x; asm volatile("" : "+v"(t)); return t; }
DEV int tok_mv(int tok) { return tok < TLAT ? (tok >> 12) : 8; }
DEV const float* xsrc(const Params& p, int tok, bool orig) {
  if (tok < TLAT) return (orig ? p.in[I_X] : p.out) + (size_t)tok * D;
  return (orig ? p.in[I_CTX] : (const float*)(p.ws + OFF_XCTX)) + (size_t)(tok - TLAT) * D;
}
DEV float* xdst(const Params& p, int tok) {
  if (tok < TLAT) return p.out + (size_t)tok * D;
  return (float*)(p.ws + OFF_XCTX) + (size_t)(tok - TLAT) * D;
}
DEV const float* modp(const Params& p, int li, int mv, int chunk) { return (const float*)(p.ws + OFF_MOD) + ((size_t)(li * 9 + mv) * 6 + chunk) * 1024; }

DEV void conv8(const u16* P, int ld, int tok, bool hp, bool hn, int col, const float* cw, int cwld, float* out) {
  const u16* r = P + (size_t)tok * ld + col;
  uint4 z = make_uint4(0, 0, 0, 0);
  uint4 v1 = *(const uint4*)r;
  uint4 v0 = hp ? *(const uint4*)(r - ld) : z;
  uint4 v2 = hn ? *(const uint4*)(r + ld) : z;
  float a[8], b[8], c[8];
  unpack8(v0, a); unpack8(v1, b); unpack8(v2, c);
  float4 w0a = *(const float4*)(cw), w0b = *(const float4*)(cw + 4);
  float4 w1a = *(const float4*)(cw + cwld), w1b = *(const float4*)(cw + cwld + 4);
  float4 w2a = *(const float4*)(cw + 2 * cwld), w2b = *(const float4*)(cw + 2 * cwld + 4);
  const float w0[8] = {w0a.x, w0a.y, w0a.z, w0a.w, w0b.x, w0b.y, w0b.z, w0b.w};
  const float w1[8] = {w1a.x, w1a.y, w1a.z, w1a.w, w1b.x, w1b.y, w1b.z, w1b.w};
  const float w2[8] = {w2a.x, w2a.y, w2a.z, w2a.w, w2b.x, w2b.y, w2b.z, w2b.w};
#pragma unroll
  for (int j = 0; j < 8; ++j) out[j] = a[j] * w0[j] + b[j] * w1[j] + c[j] * w2[j];
}
DEV void tok_nb(int tok, bool& hp, bool& hn) {
  if (tok < TLAT) { int t = tok & 4095; hp = t > 0; hn = t < 4095; }
  else { int t = (tok - TLAT) & 255; hp = t > 0; hn = t < 255; }
}

template <int BM, int BN, int WM, int WN, class AL, class BL, class EP>
DEV void gemm_tile(unsigned char* lds, int K, AL aload, BL bload, EP epi) {
  constexpr int LDT = 72;
  constexpr int TM = BM / WM / 16, TN = BN / WN / 16;
  constexpr int NA = BM * 8 / 256, NBc = BN * 8 / 256;
  u16* As = (u16*)lds;
  u16* Bs = As + BM * LDT;
  const int tid = opaque_tid(), lane = tid & 63, wave = tid >> 6;
  const int wm = wave / WN, wn = wave % WN;
  const int c = lane & 15, quad = lane >> 4;
  f32x4 acc[TM][TN];
#pragma unroll
  for (int i = 0; i < TM; ++i)
#pragma unroll
    for (int j = 0; j < TN; ++j) acc[i][j] = (f32x4){0.f, 0.f, 0.f, 0.f};
  uint4 ra[NA], rb[NBc];
#pragma unroll
  for (int i = 0; i < NA; ++i) { int id = tid + 256 * i; ra[i] = aload(id >> 3, (id & 7) * 8); }
#pragma unroll
  for (int i = 0; i < NBc; ++i) { int id = tid + 256 * i; rb[i] = bload(id >> 3, (id & 7) * 8); }
  const int nk = K / 64;
  for (int kt = 0; kt < nk; ++kt) {
    __syncthreads();
#pragma unroll
    for (int i = 0; i < NA; ++i) { int id = tid + 256 * i; *(uint4*)(As + (id >> 3) * LDT + (id & 7) * 8) = ra[i]; }
#pragma unroll
    for (int i = 0; i < NBc; ++i) { int id = tid + 256 * i; *(uint4*)(Bs + (id >> 3) * LDT + (id & 7) * 8) = rb[i]; }
    __syncthreads();
    if (kt + 1 < nk) {
      const int k0 = (kt + 1) * 64;
#pragma unroll
      for (int i = 0; i < NA; ++i) { int id = tid + 256 * i; ra[i] = aload(id >> 3, k0 + (id & 7) * 8); }
#pragma unroll
      for (int i = 0; i < NBc; ++i) { int id = tid + 256 * i; rb[i] = bload(id >> 3, k0 + (id & 7) * 8); }
    }
#pragma unroll (TN >= 8 ? 1 : 2)
    for (int ks = 0; ks < 2; ++ks) {
      bf16x8 af[TM], bfr[TN];
#pragma unroll
      for (int i = 0; i < TM; ++i) af[i] = *(const bf16x8*)(As + (wm * (BM / WM) + i * 16 + c) * LDT + ks * 32 + quad * 8);
#pragma unroll
      for (int j = 0; j < TN; ++j) bfr[j] = *(const bf16x8*)(Bs + (wn * (BN / WN) + j * 16 + c) * LDT + ks * 32 + quad * 8);
#pragma unroll
      for (int i = 0; i < TM; ++i)
#pragma unroll
        for (int j = 0; j < TN; ++j) acc[i][j] = mfma16(af[i], bfr[j], acc[i][j]);
    }
  }
  __syncthreads();
#pragma unroll
  for (int i = 0; i < TM; ++i)
#pragma unroll
    for (int j = 0; j < TN; ++j) epi(wm * (BM / WM) + i * 16 + quad * 4, wn * (BN / WN) + j * 16 + c, acc[i][j]);
}

DEV void transpose_item(const float* W, int K, int N, u16* Wt, int item, unsigned char* lds, int ntn) {
  float* tile = (float*)lds;
  const int kb = item / ntn, nb = item % ntn;
  const int tid = opaque_tid();
  __syncthreads();
#pragma unroll
  for (int i = 0; i < 16; ++i) {
    int kk = i * 4 + (tid >> 6), nn = tid & 63;
    int n = nb * 64 + nn;
    tile[kk * 65 + nn] = (n < N) ? W[(size_t)(kb * 64 + kk) * N + n] : 0.f;
  }
  __syncthreads();
  const int nl = tid >> 2, kq = tid & 3;
  float f[16];
#pragma unroll
  for (int j = 0; j < 16; ++j) f[j] = tile[(kq * 16 + j) * 65 + nl];
  u16* dst = Wt + (size_t)(nb * 64 + nl) * K + kb * 64 + kq * 16;
  *(uint4*)dst = pack8(f);
  *(uint4*)(dst + 8) = pack8(f + 8);
}

DEV void phase0a(const Params& p, unsigned char* lds) {
  const int tid = opaque_tid();
  if (blockIdx.x == 0 && tid < 64) ((unsigned*)(p.ws + OFF_CTR))[tid] = 0u;
  if (blockIdx.x == 0) { for (int i = tid; i < 1024; i += 256) ((unsigned*)(p.ws + OFF_BAR))[i] = 0u; }
  constexpr int J_WIN = 2 * 16 * 42, J_WOUT = 2 * 16 * 16, J_WQ = 2 * 16 * 32, J_WUQ = 2 * 4 * 9, J_WUKV = 2 * 2 * 12,
                J_DU = 4 * 6, J_AU = 4 * 6, J_GU = 2 * 2 * 6, J_KEYS = 256, J_MOD = 192, J_H2 = 2176, J_TW = 16, J_ROPE = 256;
  constexpr int TOTAL = J_WIN + J_WOUT + J_WQ + J_WUQ + J_WUKV + J_DU + J_AU + J_GU + J_KEYS + J_MOD + J_H2 + J_TW + J_ROPE;
  for (int item = blockIdx.x; item < TOTAL; item += gridDim.x) {
    int r = item;
    if (r < J_WIN) { int li = r / 672; r %= 672; transpose_item(p.in[I_WIN] + (size_t)li * 1024 * 2592, 1024, 2592, (u16*)(p.ws + OFF_WIN) + (size_t)li * 2688 * 1024, r, lds, 42); continue; } r -= J_WIN;
    if (r < J_WOUT) { int li = r / 256; r %= 256; transpose_item(p.in[I_WOUT] + (size_t)li * 1024 * 1024, 1024, 1024, (u16*)(p.ws + OFF_WOUT) + (size_t)li * 1024 * 1024, r, lds, 16); continue; } r -= J_WOUT;
    if (r < J_WQ) { int li = r / 512; r %= 512; transpose_item(p.in[I_PWQ] + (size_t)li * 1024 * 2048, 1024, 2048, (u16*)(p.ws + OFF_WQ) + (size_t)li * 2048 * 1024, r, lds, 32); continue; } r -= J_WQ;
    if (r < J_WUQ) { int li = r / 36; r %= 36; transpose_item(p.in[I_MWUQ] + (size_t)li * 256 * 576, 256, 576, (u16*)(p.ws + OFF_WUQ) + (size_t)li * 576 * 256, r, lds, 9); continue; } r -= J_WUQ;
    if (r < J_WUKV) { int li = r / 24; r %= 24; transpose_item(p.in[I_MWUKV] + (size_t)li * 128 * 768, 128, 768, (u16*)(p.ws + OFF_WUKV) + (size_t)li * 768 * 128, r, lds, 12); continue; } r -= J_WUKV;
    if (r < J_DU) { int m = r / 6; r %= 6; transpose_item(p.in[I_RWDUP] + (size_t)m * 64 * 384, 64, 384, (u16*)(p.ws + OFF_DUT) + (size_t)m * 384 * 64, r, lds, 6); continue; } r -= J_DU;
    if (r < J_AU) { int m = r / 6; r %= 6; transpose_item(p.in[I_RWAUP] + (size_t)m * 64 * 384, 64, 384, (u16*)(p.ws + OFF_AUT) + (size_t)m * 384 * 64, r, lds, 6); continue; } r -= J_AU;
    if (r < J_GU) { int li = r / 12; r %= 12; transpose_item(p.in[I_RWGUP] + (size_t)li * 128 * 384, 128, 384, (u16*)(p.ws + OFF_GUT) + (size_t)li * 384 * 128, r, lds, 6); continue; } r -= J_GU;
    if (r < J_KEYS) {
      const float* src = p.in[I_PKEYS] + (size_t)r * 2048 + tid * 8;
      float4 a = *(const float4*)src, b = *(const float4*)(src + 4);
      float f[8] = {a.x, a.y, a.z, a.w, b.x, b.y, b.z, b.w};
      *(uint4*)((u16*)(p.ws + OFF_KEYS) + (size_t)r * 2048 + tid * 8) = pack8(f);
      continue;
    } r -= J_KEYS;
    if (r < J_MOD) {
      const int li = r / 96, n0 = (r % 96) * 64;
      float* sc = (float*)lds;
      float* red = sc + 9 * 1024;
      __syncthreads();
      for (int i = tid; i < 9 * 1024; i += 256) {
        int mv = i >> 10, k = i & 1023;
        float v = (mv < 8) ? p.in[I_C][mv * 1024 + k] : p.in[I_CCTX][k];
        sc[i] = v * sigmoidf_(v);
      }
      __syncthreads();
      const int lane = tid & 63, wave = tid >> 6;
      float acc[9];
#pragma unroll
      for (int m = 0; m < 9; ++m) acc[m] = 0.f;
      const float* w = p.in[I_MODW] + (size_t)li * 1024 * 6144 + n0 + lane;
#pragma unroll 16
      for (int k = wave * 256; k < wave * 256 + 256; ++k) {
        float wv = w[(size_t)k * 6144];
#pragma unroll
        for (int m = 0; m < 9; ++m) acc[m] += sc[m * 1024 + k] * wv;
      }
#pragma unroll
      for (int m = 0; m < 9; ++m) red[(wave * 9 + m) * 64 + lane] = acc[m];
      __syncthreads();
      for (int i = tid; i < 9 * 64; i += 256) {
        int m = i >> 6, l = i & 63;
        float s = red[(0 * 9 + m) * 64 + l] + red[(1 * 9 + m) * 64 + l] + red[(2 * 9 + m) * 64 + l] + red[(3 * 9 + m) * 64 + l];
        ((float*)(p.ws + OFF_MOD))[(size_t)(li * 9 + m) * 6144 + n0 + l] = s + p.in[I_MODB][li * 6144 + n0 + l];
      }
      continue;
    } r -= J_MOD;
    if (r < J_H2) {
      const int li = r / 1088; const int q4 = r % 1088;
      const int tl = tid >> 6, j = tid & 63;
      const int row = q4 * 4 + tl;
      const float tn = row < 4096 ? (float)row / 4096.f : (float)(row - 4096) / 256.f;
      float* h1s = (float*)lds;
      __syncthreads();
      const float* w1 = p.in[I_HYW1] + (size_t)li * 33 * 64;
      float a = tn * w1[j];
#pragma unroll 4
      for (int k = 1; k <= 16; ++k) {
        float rev = tn * (float)k;
        a += __builtin_amdgcn_cosf(rev) * w1[k * 64 + j] + __builtin_amdgcn_sinf(rev) * w1[(16 + k) * 64 + j];
      }
      a = fsin(p.in[I_HYF1][li * 64 + j] * (a + p.in[I_HYB1][li * 64 + j]));
      h1s[tl * 64 + j] = a;
      __syncthreads();
      const float* w2 = p.in[I_HYW2] + (size_t)li * 64 * 64;
      float b = 0.f;
#pragma unroll 8
      for (int i = 0; i < 64; ++i) b += h1s[tl * 64 + i] * w2[i * 64 + j];
      b = fsin(p.in[I_HYF2][li * 64 + j] * (b + p.in[I_HYB2][li * 64 + j]));
      ((float*)(p.ws + OFF_H2))[((size_t)li * 4352 + row) * 64 + j] = b;
      continue;
    } r -= J_H2;
    if (r < J_TW) {
      int k = r * 256 + tid;
      float rev = (float)k / 8192.f;
      float2 w; w.x = __builtin_amdgcn_cosf(rev); w.y = -__builtin_amdgcn_sinf(rev);
      ((float2*)(p.ws + OFF_TW))[k] = w;
      continue;
    } r -= J_TW;
    {
      int e = r * 256 + tid;
      int l = e >> 4, ai = e & 15, a = ai >> 3, i = ai & 7;
      float pos = a == 0 ? (float)(l >> 6) : (float)(l & 63);
      float inv = exp2f(-(float)i * (13.287712379549449f / 8.f));
      float ang = pos * inv;
      ((float*)(p.ws + OFF_ROPE))[e] = fcos(ang);
      ((float*)(p.ws + OFF_ROPE))[65536 + e] = fsin(ang);
    }
  }
}

DEV void norm_row_store(const float* xr, const float* gain, const float* sc, const float* sh, u16* dst, int lane) {
  float4 v[4]; float ss = 0.f;
#pragma unroll
  for (int j = 0; j < 4; ++j) { v[j] = *(const float4*)(xr + j * 256 + lane * 4); ss += v[j].x * v[j].x + v[j].y * v[j].y + v[j].z * v[j].z + v[j].w * v[j].w; }
  ss = wave_sum(ss);
  const float rstd = rsqrtf(ss * (1.f / 1024.f) + 1e-6f);
#pragma unroll
  for (int j = 0; j < 4; ++j) {
    const int n = j * 256 + lane * 4;
    float4 g = *(const float4*)(gain + n), s = *(const float4*)(sc + n), h = *(const float4*)(sh + n);
    uint2 o;
    o.x = pack2(v[j].x * rstd * g.x * (1.f + s.x) + h.x, v[j].y * rstd * g.y * (1.f + s.y) + h.y);
    o.y = pack2(v[j].z * rstd * g.z * (1.f + s.z) + h.z, v[j].w * rstd * g.w * (1.f + s.w) + h.w);
    *(uint2*)(dst + n) = o;
  }
}
DEV void norm_pass(const Params& p, int li, bool orig, const float* gain, int sc_chunk, int sh_chunk, int ntok) {
  const int tid_ = opaque_tid(); const int lane = tid_ & 63, wave = tid_ >> 6;
#pragma unroll 2
  for (int item = blockIdx.x; item < ntok / 4; item += gridDim.x) {
    const int tok = item * 4 + wave;
    const int mv = tok_mv(tok);
    norm_row_store(xsrc(p, tok, orig), gain, modp(p, li, mv, sc_chunk), modp(p, li, mv, sh_chunk), (u16*)(p.ws + OFF_XN) + (size_t)tok * D, lane);
  }
}

DEV float2 cmul(float2 a, float2 b) { return make_float2(a.x * b.x - a.y * b.y, a.x * b.y + a.y * b.x); }
DEV float2* stage_tw(const Params& p, unsigned char* lds) {
  float2* TWs = (float2*)(lds + 65536);
  const float2* TWg = (const float2*)(p.ws + OFF_TW);
  const int tid = opaque_tid();
  __syncthreads();
  for (int i = tid; i < 4096; i += 256) TWs[i] = TWg[i];
  __syncthreads();
  return TWs;
}
DEV float2 cadd(float2 a, float2 b) { return make_float2(a.x + b.x, a.y + b.y); }
DEV float2 csub(float2 a, float2 b) { return make_float2(a.x - b.x, a.y - b.y); }
DEV float2 cconj(float2 a) { return make_float2(a.x, -a.y); }
DEV void fft_fwd(float2* buf, int logn, const float2* TW) {
  const int tid = opaque_tid();
  const int sh = 13 - logn, nq = 1 << (logn - 2);
  for (int s = logn - 1; s >= 1; s -= 2) {
    const int h1 = 1 << s, h2 = h1 >> 1;
#pragma unroll 2
    for (int i = tid; i < nq; i += 256) {
      const int p = i & (h2 - 1);
      const int a = ((i >> (s - 1)) << (s + 1)) + p;
      const float2 w1a = TW[(p << (logn - 1 - s)) << sh], w1b = TW[((p + h2) << (logn - 1 - s)) << sh], w2 = TW[(p << (logn - s)) << sh];
      const float2 x0 = buf[a], x1 = buf[a + h2], x2 = buf[a + h1], x3 = buf[a + h1 + h2];
      const float2 y0 = cadd(x0, x2), y2 = cmul(csub(x0, x2), w1a);
      const float2 y1 = cadd(x1, x3), y3 = cmul(csub(x1, x3), w1b);
      buf[a] = cadd(y0, y1); buf[a + h2] = cmul(csub(y0, y1), w2);
      buf[a + h1] = cadd(y2, y3); buf[a + h1 + h2] = cmul(csub(y2, y3), w2);
    }
    __syncthreads();
  }
  {
    const int nh = 1 << (logn - 1);
#pragma unroll 2
    for (int i = tid; i < nh; i += 256) {
      const float2 x = buf[2 * i], y = buf[2 * i + 1];
      buf[2 * i] = cadd(x, y); buf[2 * i + 1] = csub(x, y);
    }
    __syncthreads();
  }
}
DEV void fft_inv(float2* buf, int logn, const float2* TW) {
  const int tid = opaque_tid();
  const int sh = 13 - logn, nq = 1 << (logn - 2);
  {
    const int nh = 1 << (logn - 1);
#pragma unroll 2
    for (int i = tid; i < nh; i += 256) {
      const float2 x = buf[2 * i], y = buf[2 * i + 1];
      buf[2 * i] = cadd(x, y); buf[2 * i + 1] = csub(x, y);
    }
    __syncthreads();
  }
  for (int s = 2; s <= logn - 1; s += 2) {
    const int h1 = 1 << s, h2 = h1 >> 1;
#pragma unroll 2
    for (int i = tid; i < nq; i += 256) {
      const int p = i & (h2 - 1);
      const int a = ((i >> (s - 1)) << (s + 1)) + p;
      const float2 w1a = cconj(TW[(p << (logn - 1 - s)) << sh]), w1b = cconj(TW[((p + h2) << (logn - 1 - s)) << sh]), w2 = cconj(TW[(p << (logn - s)) << sh]);
      const float2 z0 = buf[a], z1 = buf[a + h2], z2 = buf[a + h1], z3 = buf[a + h1 + h2];
      const float2 t1 = cmul(z1, w2), t3 = cmul(z3, w2);
      const float2 y0 = cadd(z0, t1), y1 = csub(z0, t1), y2 = cadd(z2, t3), y3 = csub(z2, t3);
      const float2 u2 = cmul(y2, w1a), u3 = cmul(y3, w1b);
      buf[a] = cadd(y0, u2); buf[a + h1] = csub(y0, u2);
      buf[a + h2] = cadd(y1, u3); buf[a + h1 + h2] = csub(y1, u3);
    }
    __syncthreads();
  }
}

DEV void mla_item(const Params& p, int li, int item, unsigned char* lds) {
  const int tid = opaque_tid(), lane = tid & 63, wave = tid >> 6;
  const int tok0 = item * 64 + wave * 16;
  __syncthreads();
  u16* Aq = (u16*)(lds + wave * 15360);
  u16* Akv = Aq + 16 * 264;
  float* KR = (float*)(Akv + 16 * 136);
  float* SSR = KR + 16 * 32;
  const u16* Pmh = (const u16*)(p.ws + OFF_PMH);
  const bool lat = tok0 < TLAT;
  const int b = lat ? (tok0 >> 12) : ((tok0 - TLAT) >> 8);
  const int kidx0 = lat ? (tok0 & 4095) : (4096 + ((tok0 - TLAT) & 255));
  {
    const int row = lane >> 2, sub = lane & 3;
    const u16* rp = Pmh + (size_t)(tok0 + row) * 1184;
    uint4 v[13];
#pragma unroll
    for (int i = 0; i < 13; ++i) v[i] = *(const uint4*)(rp + (sub + 4 * i) * 8);
    float ssq = 0.f, sskv = 0.f, ssr = 0.f;
    float f[8];
#pragma unroll
    for (int i = 0; i < 13; ++i) {
      unpack8(v[i], f);
      float s = 0.f;
#pragma unroll
      for (int j = 0; j < 8; ++j) s += f[j] * f[j];
      if (i < 8) ssq += s; else if (i < 12) sskv += s; else ssr += s;
    }
    ssq = sum4(ssq); sskv = sum4(sskv); ssr = sum4(ssr);
    const float rq = rsqrtf(ssq * (1.f / 256.f) + 1e-6f), rkv = rsqrtf(sskv * (1.f / 128.f) + 1e-6f);
    const float* qn = p.in[I_MQNORM] + li * 256;
    const float* kvn = p.in[I_MKVNORM] + li * 128;
#pragma unroll
    for (int i = 0; i < 13; ++i) {
      unpack8(v[i], f);
      if (i < 8) {
        const int col = (sub + 4 * i) * 8;
#pragma unroll
        for (int j = 0; j < 8; ++j) f[j] = f[j] * rq * qn[col + j];
        *(uint4*)(Aq + row * 264 + col) = pack8(f);
      } else if (i < 12) {
        const int col = (sub + 4 * i - 32) * 8;
#pragma unroll
        for (int j = 0; j < 8; ++j) f[j] = f[j] * rkv * kvn[col + j];
        *(uint4*)(Akv + row * 136 + col) = pack8(f);
      } else {
#pragma unroll
        for (int j = 0; j < 8; ++j) KR[row * 32 + sub * 8 + j] = f[j];
      }
    }
    if (sub == 0) SSR[row] = ssr;
  }
  __builtin_amdgcn_fence(__ATOMIC_RELEASE, "wavefront");
  __builtin_amdgcn_wave_barrier();
  __builtin_amdgcn_fence(__ATOMIC_ACQUIRE, "wavefront");
  const int c = lane & 15, quad = lane >> 4;
  const float* RC = (const float*)(p.ws + OFF_ROPE);
  const float* RS = RC + 65536;
  const float QSCALE = 0.10206207261596577f * 1.4426950408889634f;
  u16* QB = (u16*)(p.ws + OFF_QB);
  u16* KB = (u16*)(p.ws + OFF_KB);
  u16* VT = (u16*)(p.ws + OFF_VT);
  {
    const u16* W = (const u16*)(p.ws + OFF_WUQ) + (size_t)li * 576 * 256;
    const float* qg = p.in[I_MQGAIN] + li * 96;
#pragma unroll 1
    for (int h = 0; h < 6; ++h) {
      f32x4 acc[6];
#pragma unroll
      for (int j = 0; j < 6; ++j) acc[j] = (f32x4){0.f, 0.f, 0.f, 0.f};
#pragma unroll
      for (int ks = 0; ks < 8; ++ks) {
        const bf16x8 af = *(const bf16x8*)(Aq + c * 264 + ks * 32 + quad * 8);
#pragma unroll
        for (int j = 0; j < 6; ++j) {
          bf16x8 bb = *(const bf16x8*)(W + (size_t)(h * 96 + j * 16 + c) * 256 + ks * 32 + quad * 8);
          acc[j] = mfma16(af, bb, acc[j]);
        }
      }
#pragma unroll
      for (int r = 0; r < 4; ++r) {
        float s = 0.f;
#pragma unroll
        for (int j = 0; j < 6; ++j) s += acc[j][r] * acc[j][r];
        s = sum16(s);
        const float rs = rsqrtf(s * (1.f / 96.f) + 1e-6f) * QSCALE;
        const int rowi = quad * 4 + r;
        u16* dst = QB + ((size_t)(b * 6 + h) * KTOT + kidx0 + rowi) * 96;
#pragma unroll
        for (int j = 0; j < 4; ++j) dst[j * 16 + c] = f2bf(acc[j][r] * rs * qg[j * 16 + c]);
#pragma unroll
        for (int j = 4; j < 6; ++j) {
          float x = acc[j][r] * rs * qg[j * 16 + c];
          if (lat) {
            const float pr = __shfl_xor(x, 8);
            const int t = kidx0 + rowi;
            const float cs = RC[t * 16 + (j - 4) * 8 + (c & 7)], sn = RS[t * 16 + (j - 4) * 8 + (c & 7)];
            x = (c < 8) ? (x * cs - pr * sn) : (x * cs + pr * sn);
          }
          dst[j * 16 + c] = f2bf(x);
        }
      }
    }
  }
  {
    const u16* W = (const u16*)(p.ws + OFF_WUKV) + (size_t)li * 768 * 128;
    const float* kg = p.in[I_MKGAIN] + li * 96;
#pragma unroll 1
    for (int h = 0; h < 6; ++h) {
      f32x4 acc[8];
#pragma unroll
      for (int j = 0; j < 8; ++j) acc[j] = (f32x4){0.f, 0.f, 0.f, 0.f};
#pragma unroll
      for (int ks = 0; ks < 4; ++ks) {
        const bf16x8 af = *(const bf16x8*)(Akv + c * 136 + ks * 32 + quad * 8);
#pragma unroll
        for (int j = 0; j < 8; ++j) {
          bf16x8 bb = *(const bf16x8*)(W + (size_t)(h * 128 + j * 16 + c) * 128 + ks * 32 + quad * 8);
          acc[j] = mfma16(af, bb, acc[j]);
        }
      }
#pragma unroll
      for (int r = 0; r < 4; ++r) {
        const int rowi = quad * 4 + r;
        float s = 0.f;
#pragma unroll
        for (int j = 0; j < 4; ++j) s += acc[j][r] * acc[j][r];
        s = sum16(s);
        s += SSR[rowi];
        const float rk = rsqrtf(s * (1.f / 96.f) + 1e-6f);
        u16* dk = KB + ((size_t)(b * 6 + h) * KTOT + kidx0 + rowi) * 96;
#pragma unroll
        for (int j = 0; j < 4; ++j) dk[j * 16 + c] = f2bf(acc[j][r] * rk * kg[j * 16 + c]);
#pragma unroll
        for (int jj = 0; jj < 2; ++jj) {
          float x = KR[rowi * 32 + jj * 16 + c] * rk * kg[64 + jj * 16 + c];
          if (lat) {
            const float pr = KR[rowi * 32 + jj * 16 + (c ^ 8)] * rk * kg[64 + jj * 16 + (c ^ 8)];
            const int t = kidx0 + rowi;
            const float cs = RC[t * 16 + jj * 8 + (c & 7)], sn = RS[t * 16 + jj * 8 + (c & 7)];
            x = (c < 8) ? (x * cs - pr * sn) : (x * cs + pr * sn);
          }
          dk[64 + jj * 16 + c] = f2bf(x);
        }
#pragma unroll
        for (int j = 0; j < 4; ++j) VT[((size_t)(b * 6 + h) * 64 + j * 16 + c) * KTOT + kidx0 + rowi] = f2bf(acc[4 + j][r]);
      }
    }
  }
  __builtin_amdgcn_wave_barrier();
}

DEV void hy_item(const Params& p, int li, int part, int tt, unsigned char* lds) {
  const int tid = opaque_tid();
  u16* Z = (u16*)lds;
  int b, t0, L, tokbase; size_t obase;
  if (tt < 512) { b = tt >> 6; t0 = (tt & 63) * 64; L = 4096; tokbase = b * 4096; obase = (size_t)b * 256 * 4096; }
  else { int u = tt - 512; b = u >> 2; t0 = (u & 3) * 64; L = 256; tokbase = TLAT + b * 256; obase = (size_t)8 * 256 * 4096 + (size_t)b * 256 * 256; }
  const u16* Pmh = (const u16*)(p.ws + OFF_PMH);
  __syncthreads();
  for (int id = tid; id < 66 * 32; id += 256) {
    const int rr = id >> 5, ch = id & 31;
    const int t = t0 - 1 + rr;
    uint4 v = make_uint4(0, 0, 0, 0);
    if (t >= 0 && t < L) v = *(const uint4*)(Pmh + (size_t)(tokbase + t) * 1184 + 416 + part * 256 + ch * 8);
    *(uint4*)(Z + rr * 264 + ch * 8) = v;
  }
  __syncthreads();
  const int c = tid;
  const float* cw = p.in[I_HYCONV] + (size_t)li * 3 * 768 + part * 256 + c;
  const float w0 = cw[0], w1 = cw[768], w2 = cw[1536];
  u16* dst = (u16*)(p.ws + OFF_HYIN) + (size_t)part * TT * 256 + obase + (size_t)c * L + t0;
#pragma unroll
  for (int g = 0; g < 8; ++g) {
    float f[8];
#pragma unroll
    for (int j = 0; j < 8; ++j) {
      const int t = g * 8 + j;
      f[j] = w0 * bf2f(Z[t * 264 + c]) + w1 * bf2f(Z[(t + 1) * 264 + c]) + w2 * bf2f(Z[(t + 2) * 264 + c]);
    }
    *(uint4*)(dst + g * 8) = pack8(f);
  }
}

DEV void rwg_item(const Params& p, int li, int item, unsigned char* lds) {
  const int tid = opaque_tid(), lane = tid & 63, wave = tid >> 6;
  const int tok0 = item * 64 + wave * 16;
  __syncthreads();
  u16* Ag = (u16*)(lds + wave * 16384);
  u16* BV = Ag + 16 * 128;
  const u16* Prw = (const u16*)(p.ws + OFF_PRW);
  const float* cw = p.in[I_RWCONV] + (size_t)li * 3 * 1408;
#pragma unroll
  for (int i = 0; i < 4; ++i) {
    const int unit = lane + 64 * i, row = unit >> 4, c8 = unit & 15;
    const int tok = tok0 + row; bool hp, hn; tok_nb(tok, hp, hn);
    float f[8];
    conv8(Prw, 1408, tok, hp, hn, 1280 + c8 * 8, cw + 1280 + c8 * 8, 1408, f);
#pragma unroll
    for (int j = 0; j < 8; ++j) f[j] = sigmoidf_(f[j]);
    *(uint4*)(Ag + row * 128 + c8 * 8) = pack8(f);
  }
  const float* rk = p.in[I_RWRK] + li * 384;
  for (int it = 0; it < 12; ++it) {
    const int rh = it / 6, h = it % 6;
    const int row = rh * 8 + (lane >> 3), c8 = lane & 7;
    const int tok = tok0 + row; bool hp, hn; tok_nb(tok, hp, hn);
    const int col = h * 64 + c8 * 8;
    float r8[8], k8[8], v8[8];
    conv8(Prw, 1408, tok, hp, hn, col, cw + col, 1408, r8);
    conv8(Prw, 1408, tok, hp, hn, 384 + col, cw + 384 + col, 1408, k8);
    conv8(Prw, 1408, tok, hp, hn, 768 + col, cw + 768 + col, 1408, v8);
    float s = 0.f;
#pragma unroll
    for (int j = 0; j < 8; ++j) s += r8[j] * k8[j] * rk[col + j];
    s = sum8(s);
#pragma unroll
    for (int j = 0; j < 8; ++j) v8[j] *= s;
    *(uint4*)(BV + row * 384 + col) = pack8(v8);
  }
  __builtin_amdgcn_fence(__ATOMIC_RELEASE, "wavefront");
  __builtin_amdgcn_wave_barrier();
  __builtin_amdgcn_fence(__ATOMIC_ACQUIRE, "wavefront");
  const int c = lane & 15, quad = lane >> 4;
  bf16x8 af[4];
#pragma unroll
  for (int ks = 0; ks < 4; ++ks) af[ks] = *(const bf16x8*)(Ag + c * 128 + ks * 32 + quad * 8);
  const u16* W = (const u16*)(p.ws + OFF_GUT) + (size_t)li * 384 * 128;
  u16* G = (u16*)(p.ws + OFF_G);
  u16* BG = (u16*)(p.ws + OFF_BG);
  for (int h = 0; h < 6; ++h) {
    f32x4 acc[4];
#pragma unroll
    for (int j = 0; j < 4; ++j) acc[j] = (f32x4){0.f, 0.f, 0.f, 0.f};
#pragma unroll
    for (int ks = 0; ks < 4; ++ks)
#pragma unroll
      for (int j = 0; j < 4; ++j) {
        bf16x8 bb = *(const bf16x8*)(W + (size_t)(h * 64 + j * 16 + c) * 128 + ks * 32 + quad * 8);
        acc[j] = mfma16(af[ks], bb, acc[j]);
      }
#pragma unroll
    for (int j = 0; j < 4; ++j)
#pragma unroll
      for (int r = 0; r < 4; ++r) {
        const int rowi = quad * 4 + r, col = h * 64 + j * 16 + c;
        const float g = acc[j][r];
        G[(size_t)(tok0 + rowi) * 384 + col] = f2bf(g);
        BG[(size_t)(tok0 + rowi) * 384 + col] = f2bf(g * bf2f(BV[rowi * 384 + col]));
      }
  }
  __builtin_amdgcn_wave_barrier();
}

DEV void filt_item(const Params& p, int li, int sel, int o, int c, unsigned char* lds, const float2* TWs) {
  const int tid = opaque_tid();
  const int L = sel ? 256 : 4096, logn = sel ? 9 : 13, N2 = 2 * L;
  float2* buf = (float2*)lds;
  const int col0 = o * 512 + c, col1 = col0 + 256;
  __syncthreads();
  const float* w3a = p.in[I_HYW3] + (size_t)li * 64 * 1024 + col0;
  const float* w3b = w3a + 256;
  const float b30 = p.in[I_HYB3][li * 1024 + col0], b31 = p.in[I_HYB3][li * 1024 + col1];
  const float rate = 3.0701134573253946f + (15.350567286626972f - 3.0701134573253946f) * (float)c * (1.f / 255.f);
  const float* H2 = (const float*)(p.ws + OFF_H2) + ((size_t)li * 4352 + (sel ? 4096 : 0)) * 64;
  float ss = 0.f;
#pragma unroll 1
  for (int dd = 0; dd < 2; ++dd) {
    const float* w3 = dd ? w3b : w3a;
    const float b3v = dd ? b31 : b30;
    for (int t = tid; t < L; t += 256) {
      const float4* hr = (const float4*)(H2 + (size_t)t * 64);
      float d0 = b3v;
#pragma unroll
      for (int i = 0; i < 16; ++i) {
        float4 h = hr[i];
        d0 += h.x * w3[(i * 4) * 1024] + h.y * w3[(i * 4 + 1) * 1024] + h.z * w3[(i * 4 + 2) * 1024] + h.w * w3[(i * 4 + 3) * 1024];
      }
      const float v0 = d0 * __expf(-((float)t / (float)L) * rate);
      if (dd == 0) { buf[t] = make_float2(v0, 0.f); ss += v0 * v0; }
      else if (t >= 1) { buf[N2 - t] = make_float2(v0, 0.f); ss += v0 * v0; }
    }
  }
  ss = wave_sum(ss);
  float tot = 0.f;
  if ((tid & 63) == 0 && tid < 128) ((float*)&buf[L])[tid >> 6] = ss;
  __syncthreads();
  tot += buf[L].x + buf[L].y;
  __syncthreads();
  if ((tid & 63) == 0 && tid >= 128) ((float*)&buf[L])[(tid >> 6) - 2] = ss;
  __syncthreads();
  tot += buf[L].x + buf[L].y;
  __syncthreads();
  if (tid == 0) buf[L] = make_float2(0.f, 0.f);
  __syncthreads();
  const float scale = rsqrtf(tot) / (float)N2;
  fft_fwd(buf, logn, TWs);
  float2* HF = (float2*)(p.ws + OFF_HF) + (sel ? (size_t)2 * 256 * 8192 : 0) + (size_t)(o * 256 + c) * N2;
  for (int i = tid; i < N2; i += 256) { float2 v = buf[i]; HF[i] = make_float2(v.x * scale, v.y * scale); }
}

DEV void phaseA(const Params& p, int li, unsigned char* lds) {
  const u16* XN = (const u16*)(p.ws + OFF_XN);
  const u16* Wt = (const u16*)(p.ws + OFF_WIN) + (size_t)li * 2688 * 1024;
  u16* Prw = (u16*)(p.ws + OFF_PRW);
  u16* Pmh = (u16*)(p.ws + OFF_PMH);
  const int n_filt = (li == 0) ? 1024 : 512;
  const float2* TWs = stage_tw(p, lds);
  for (int item0 = blockIdx.x; item0 < 136 * 21 + n_filt; item0 += gridDim.x) {
    if (item0 < n_filt) { const int sel = item0 >> 9, r = item0 & 511; filt_item(p, li, sel, r >> 8, r & 255, lds, TWs); continue; }
    const int item = item0 - n_filt;
    const int m0 = (item / 21) * 256, n0 = (item % 21) * 128;
    gemm_tile<256, 128, 2, 2>(lds, 1024,
      [&](int row, int k) { return *(const uint4*)(XN + (size_t)(m0 + row) * 1024 + k); },
      [&](int row, int k) { return *(const uint4*)(Wt + (size_t)(n0 + row) * 1024 + k); },
      [&](int mrow, int ncol, f32x4 a) {
        const int n = n0 + ncol;
        if (n < 2592) {
#pragma unroll
          for (int r = 0; r < 4; ++r) {
            const int tok = m0 + mrow + r;
            if (n < 1408) Prw[(size_t)tok * 1408 + n] = f2bf(a[r]);
            else Pmh[(size_t)tok * 1184 + (n - 1408)] = f2bf(a[r]);
          }
        }
      });
  }
}


DEV void phaseB(const Params& p, int li, unsigned char* lds) {
  const bool need_ctx = (li == 0);
  const int n_mla = 544;
  const int n_hytt = need_ctx ? 544 : 512, n_hy = n_hytt * 3;
  const int n_rwg = need_ctx ? 544 : 512;
  const int total = n_mla + n_hy + n_rwg;
  for (int item = blockIdx.x; item < total; item += gridDim.x) {
    int r = item;
    if (r < n_mla) { mla_item(p, li, r, lds); continue; } r -= n_mla;
    if (r < n_hy) { hy_item(p, li, r / n_hytt, r % n_hytt, lds); continue; } r -= n_hy;
    rwg_item(p, li, r, lds);
  }
}

DEV void scan_item(const Params& p, int li, int item, unsigned char* lds) {
  const int tid = opaque_tid(), lane = tid & 63, wave = tid >> 6;
  const int dir = item & 1, bh = item >> 1, b = bh / 6, h = bh % 6;
  float* STEP = (float*)lds;
  u16* DL = (u16*)(lds + 49152);
  u16* AL = DL + 32 * 72;
  u16* YS = (u16*)(lds + 49152 + 2 * 32 * 72 * 2);
  const u16* Prw = (const u16*)(p.ws + OFF_PRW);
  const float* cw = p.in[I_RWCONV] + (size_t)li * 3 * 1408;
  const float* kkw = p.in[I_RWKK] + li * 384 + h * 64;
  const float* kaw = p.in[I_RWKA] + li * 384 + h * 64;
  const float* d0 = p.in[I_RWD0] + (size_t)(li * 2 + dir) * 384 + h * 64;
  const float* a0 = p.in[I_RWA0] + (size_t)(li * 2 + dir) * 384 + h * 64;
  const u16* DUT = (const u16*)(p.ws + OFF_DUT) + ((size_t)(li * 2 + dir) * 384 + h * 64) * 64;
  const u16* AUT = (const u16*)(p.ws + OFF_AUT) + ((size_t)(li * 2 + dir) * 384 + h * 64) * 64;
  u16* Yd = (u16*)(p.ws + (dir ? OFF_Y1 : OFF_Y0));
  const int vrow = tid >> 2, q = tid & 3;
  f32x2 S[8];
#pragma unroll
  for (int i = 0; i < 8; ++i) S[i] = (f32x2){0.f, 0.f};
  const int c = lane & 15, quad = lane >> 4;
  __syncthreads();
  for (int ch = 0; ch < 136; ++ch) {
    int tokbase, t0, L;
    if (ch < 8) { L = 256; tokbase = TLAT + b * 256; t0 = (dir ? (7 - ch) : ch) * 32; }
    else { L = 4096; tokbase = b * 4096; const int cc = ch - 8; t0 = (dir ? (127 - cc) : cc) * 32; }
#pragma unroll
    for (int i = 0; i < 5; ++i) {
      const int id = tid + 256 * i;
      const int c8 = id & 7, part = (id >> 3) % 5, tl = id / 40;
      const int t = t0 + tl, tok = tokbase + t;
      const int col = (part < 3) ? (part * 384 + h * 64 + c8 * 8) : (1152 + (part - 3) * 64 + c8 * 8);
      float f[8];
      conv8(Prw, 1408, tok, t > 0, t < L - 1, col, cw + col, 1408, f);
      float ssk = 0.f;
      float kr[8];
#pragma unroll
      for (int j = 0; j < 8; ++j) { kr[j] = f[j] * kkw[c8 * 8 + j]; ssk += kr[j] * kr[j]; }
      ssk = sum8(ssk);
      float* sp = STEP + tl * 384;
      if (part == 0) { *(float4*)(sp + 256 + c8 * 8) = make_float4(f[0], f[1], f[2], f[3]); *(float4*)(sp + 256 + c8 * 8 + 4) = make_float4(f[4], f[5], f[6], f[7]); }
      else if (part == 1) {
        *(float4*)(sp + 192 + c8 * 8) = make_float4(f[0], f[1], f[2], f[3]); *(float4*)(sp + 192 + c8 * 8 + 4) = make_float4(f[4], f[5], f[6], f[7]);
        const float rs = rsqrtf(ssk + 1e-12f);
        *(float4*)(sp + c8 * 8) = make_float4(kr[0] * rs, kr[1] * rs, kr[2] * rs, kr[3] * rs);
        *(float4*)(sp + c8 * 8 + 4) = make_float4(kr[4] * rs, kr[5] * rs, kr[6] * rs, kr[7] * rs);
      }
      else if (part == 2) { *(float4*)(sp + 320 + c8 * 8) = make_float4(f[0], f[1], f[2], f[3]); *(float4*)(sp + 320 + c8 * 8 + 4) = make_float4(f[4], f[5], f[6], f[7]); }
      else if (part == 3) {
#pragma unroll
        for (int j = 0; j < 8; ++j) f[j] = tanhf(f[j]);
        *(uint4*)(DL + tl * 72 + c8 * 8) = pack8(f);
      }
      else { *(uint4*)(AL + tl * 72 + c8 * 8) = pack8(f); }
    }
    __syncthreads();
    {
      const int mt = wave >> 1;
      bf16x8 ad[2], aa[2];
#pragma unroll
      for (int ks = 0; ks < 2; ++ks) {
        ad[ks] = *(const bf16x8*)(DL + (mt * 16 + c) * 72 + ks * 32 + quad * 8);
        aa[ks] = *(const bf16x8*)(AL + (mt * 16 + c) * 72 + ks * 32 + quad * 8);
      }
#pragma unroll
      for (int jn = 0; jn < 2; ++jn) {
        const int nt = (wave & 1) * 2 + jn;
        f32x4 accd = (f32x4){0.f, 0.f, 0.f, 0.f}, acca = accd;
#pragma unroll
        for (int ks = 0; ks < 2; ++ks) {
          bf16x8 bd = *(const bf16x8*)(DUT + (size_t)(nt * 16 + c) * 64 + ks * 32 + quad * 8);
          bf16x8 ba = *(const bf16x8*)(AUT + (size_t)(nt * 16 + c) * 64 + ks * 32 + quad * 8);
          accd = mfma16(ad[ks], bd, accd);
          acca = mfma16(aa[ks], ba, acca);
        }
        const int col = nt * 16 + c;
        const float d0c = d0[col], a0c = a0[col], kac = kaw[col];
#pragma unroll
        for (int r = 0; r < 4; ++r) {
          const int tl = mt * 16 + quad * 4 + r;
          float* sp = STEP + tl * 384;
          const float w = __expf(-0.6065306597f * sigmoidf_(d0c + accd[r]));
          const float a = sigmoidf_(a0c + acca[r]);
          const float kraw = sp[192 + col], kk = sp[col];
          sp[64 + col] = w;
          sp[128 + col] = a * kk;
          sp[192 + col] = kraw * (1.f + (a - 1.f) * kac);
        }
      }
    }
    __syncthreads();
#define SCAN_LOAD(TL, KK, W, AK, KR, RR, VV) { \
      const float* sp_ = STEP + (TL) * 384 + q * 16; \
      _Pragma("unroll") for (int i = 0; i < 4; ++i) { f32x4 t_; \
        t_ = *(const f32x4*)(sp_ + i * 4);        KK[2 * i] = t_.xy; KK[2 * i + 1] = t_.zw; \
        t_ = *(const f32x4*)(sp_ + 64 + i * 4);   W[2 * i] = t_.xy;  W[2 * i + 1] = t_.zw; \
        t_ = *(const f32x4*)(sp_ + 128 + i * 4);  AK[2 * i] = t_.xy; AK[2 * i + 1] = t_.zw; \
        t_ = *(const f32x4*)(sp_ + 192 + i * 4);  KR[2 * i] = t_.xy; KR[2 * i + 1] = t_.zw; \
        t_ = *(const f32x4*)(sp_ + 256 + i * 4);  RR[2 * i] = t_.xy; RR[2 * i + 1] = t_.zw; } \
      VV = STEP[(TL) * 384 + 320 + vrow]; }
#define SCAN_STEP(TL, KK, W, AK, KR, RR, VV) { \
      f32x2 pa = S[0] * KK[0], pb = S[1] * KK[1]; \
      _Pragma("unroll") for (int i = 2; i < 8; i += 2) { pa += S[i] * KK[i]; pb += S[i + 1] * KK[i + 1]; } \
      pa += pb; \
      float pd = sum4(pa.x + pa.y); \
      const f32x2 npd = (f32x2){-pd, -pd}, vv2 = (f32x2){VV, VV}; \
      f32x2 ya = (f32x2){0.f, 0.f}, yb = ya; \
      _Pragma("unroll") for (int i = 0; i < 8; i += 2) { \
        S[i] = S[i] * W[i] + (vv2 * KR[i] + npd * AK[i]); \
        S[i + 1] = S[i + 1] * W[i + 1] + (vv2 * KR[i + 1] + npd * AK[i + 1]); \
        ya += S[i] * RR[i]; yb += S[i + 1] * RR[i + 1]; } \
      ya += yb; \
      const float y = sum4(ya.x + ya.y); \
      if (q == 0) YS[(TL) * 64 + vrow] = f2bf(y); }
    for (int st = 0; st < 32; st += 2) {
      const int tl0 = dir ? (31 - st) : st, tl1 = dir ? (30 - st) : (st + 1);
      f32x2 kk0[8], w0[8], ak0[8], kr0[8], rr0[8], kk1[8], w1[8], ak1[8], kr1[8], rr1[8];
      float vv0, vv1;
      SCAN_LOAD(tl0, kk0, w0, ak0, kr0, rr0, vv0)
      SCAN_LOAD(tl1, kk1, w1, ak1, kr1, rr1, vv1)
      SCAN_STEP(tl0, kk0, w0, ak0, kr0, rr0, vv0)
      SCAN_STEP(tl1, kk1, w1, ak1, kr1, rr1, vv1)
    }
    __syncthreads();
    {
      const int tl = tid >> 3, c8 = tid & 7;
      *(uint4*)(Yd + (size_t)(tokbase + t0 + tl) * 384 + h * 64 + c8 * 8) = *(const uint4*)(YS + tl * 64 + c8 * 8);
    }
  }
}

DEV void attn_item(const Params& p, int b, int h, int q0, int kt0, int kt1, int tok_q0, unsigned char* lds) {
  const int tid = opaque_tid(), lane = tid & 63, wave = tid >> 6;
  const int c = lane & 15, quad = lane >> 4;
  u16* Ks = (u16*)lds;
  u16* Vs = Ks + 64 * 104;
  const size_t bh = (size_t)(b * 6 + h);
  const u16* QB = (const u16*)(p.ws + OFF_QB) + bh * KTOT * 96;
  const u16* KB = (const u16*)(p.ws + OFF_KB) + bh * KTOT * 96;
  const u16* VT = (const u16*)(p.ws + OFF_VT) + bh * 64 * KTOT;
  bf16x8 qf[4][3];
#pragma unroll
  for (int n = 0; n < 4; ++n)
#pragma unroll
    for (int ks = 0; ks < 3; ++ks) qf[n][ks] = *(const bf16x8*)(QB + (size_t)(q0 + wave * 64 + n * 16 + c) * 96 + ks * 32 + quad * 8);
  f32x4 ot[4][4];
#pragma unroll
  for (int d = 0; d < 4; ++d)
#pragma unroll
    for (int n = 0; n < 4; ++n) ot[d][n] = (f32x4){0.f, 0.f, 0.f, 0.f};
  float mrun[4] = {-1e30f, -1e30f, -1e30f, -1e30f}, lsum[4] = {0.f, 0.f, 0.f, 0.f};
  uint4 rk0, rk1, rk2, rv0, rv1;
#define ATT_KLD(KT, I) (*(const uint4*)(KB + (size_t)((KT) * 64 + (tid + 256 * (I)) / 12) * 96 + ((tid + 256 * (I)) % 12) * 8))
#define ATT_VLD(KT, I) (*(const uint4*)(VT + (size_t)((tid + 256 * (I)) >> 3) * KTOT + (KT) * 64 + ((tid + 256 * (I)) & 7) * 8))
#define ATT_GLOAD(KT) { rk0 = ATT_KLD(KT, 0); rk1 = ATT_KLD(KT, 1); rk2 = ATT_KLD(KT, 2); rv0 = ATT_VLD(KT, 0); rv1 = ATT_VLD(KT, 1); }
  ATT_GLOAD(kt0);
  for (int kt = kt0; kt < kt1; ++kt) {
    __syncthreads();
    { const int id = tid; *(uint4*)(Ks + (id / 12) * 104 + (id % 12) * 8) = rk0; }
    { const int id = tid + 256; *(uint4*)(Ks + (id / 12) * 104 + (id % 12) * 8) = rk1; }
    { const int id = tid + 512; *(uint4*)(Ks + (id / 12) * 104 + (id % 12) * 8) = rk2; }
    { const int id = tid; uint2* d = (uint2*)(Vs + (id >> 3) * 68 + (id & 7) * 8); d[0] = make_uint2(rv0.x, rv0.y); d[1] = make_uint2(rv0.z, rv0.w); }
    { const int id = tid + 256; uint2* d = (uint2*)(Vs + (id >> 3) * 68 + (id & 7) * 8); d[0] = make_uint2(rv1.x, rv1.y); d[1] = make_uint2(rv1.z, rv1.w); }
    __syncthreads();
    if (kt + 1 < kt1) ATT_GLOAD(kt + 1);
    f32x4 st[4][4];
#pragma unroll
    for (int i = 0; i < 4; ++i)
#pragma unroll
      for (int n = 0; n < 4; ++n) st[i][n] = (f32x4){0.f, 0.f, 0.f, 0.f};
#pragma unroll
    for (int ks = 0; ks < 3; ++ks)
#pragma unroll
      for (int i = 0; i < 4; ++i) {
        const bf16x8 ak = *(const bf16x8*)(Ks + (i * 16 + c) * 104 + ks * 32 + quad * 8);
#pragma unroll
        for (int n = 0; n < 4; ++n) st[i][n] = mfma16(ak, qf[n][ks], st[i][n]);
      }
    bf16x8 pb[4][2];
#pragma unroll
    for (int n = 0; n < 4; ++n) {
      float mx = st[0][n][0];
#pragma unroll
      for (int i = 0; i < 4; ++i)
#pragma unroll
        for (int r = 0; r < 4; ++r) mx = fmaxf(mx, st[i][n][r]);
      mx = fmaxf(mx, __shfl_xor(mx, 16)); mx = fmaxf(mx, __shfl_xor(mx, 32));
      const float mnew = fmaxf(mrun[n], mx);
      const float alpha = __builtin_amdgcn_exp2f(mrun[n] - mnew);
      mrun[n] = mnew;
      float ls = 0.f;
      float pv[16];
#pragma unroll
      for (int i = 0; i < 4; ++i)
#pragma unroll
        for (int r = 0; r < 4; ++r) { const float e = __builtin_amdgcn_exp2f(st[i][n][r] - mnew); pv[i * 4 + r] = e; ls += e; }
      lsum[n] = lsum[n] * alpha + ls;
      if (__builtin_amdgcn_ballot_w64(alpha != 1.0f) != 0ull) {
#pragma unroll
        for (int d = 0; d < 4; ++d) ot[d][n] *= alpha;
      }
#pragma unroll
      for (int kk = 0; kk < 2; ++kk) pb[n][kk] = as_bf8(pack8(pv + kk * 8));
    }
#pragma unroll
    for (int kk = 0; kk < 2; ++kk)
#pragma unroll
      for (int d = 0; d < 4; ++d) {
        const uint2 lo = *(const uint2*)(Vs + (d * 16 + c) * 68 + kk * 32 + quad * 4);
        const uint2 hi = *(const uint2*)(Vs + (d * 16 + c) * 68 + kk * 32 + 16 + quad * 4);
        const bf16x8 av = as_bf8(make_uint4(lo.x, lo.y, hi.x, hi.y));
#pragma unroll
        for (int n = 0; n < 4; ++n) ot[d][n] = mfma16(av, pb[n][kk], ot[d][n]);
      }
  }
  u16* ATT = (u16*)(p.ws + OFF_ATT);
#pragma unroll
  for (int n = 0; n < 4; ++n) {
    float l = lsum[n];
    l += __shfl_xor(l, 16); l += __shfl_xor(l, 32);
    const float inv = 1.f / l;
    const int tok = tok_q0 + wave * 64 + n * 16 + c;
#pragma unroll
    for (int d = 0; d < 4; ++d) {
      uint2 o;
      o.x = pack2(ot[d][n][0] * inv, ot[d][n][1] * inv);
      o.y = pack2(ot[d][n][2] * inv, ot[d][n][3] * inv);
      *(uint2*)(ATT + (size_t)tok * 384 + h * 64 + d * 16 + quad * 4) = o;
    }
  }
}

template <int NJ>
DEV void hyfft_item(const Params& p, int li, int c, int bp, unsigned char* lds, const float2* TW) {
  constexpr int L = NJ * 256, N2 = 2 * L, logn = (NJ == 16) ? 13 : 9;
  const int tid = opaque_tid();
  float2* buf = (float2*)lds;
  const size_t seqoff = (NJ == 16) ? 0 : (size_t)8 * 256 * 4096;
  const size_t o0 = seqoff + ((size_t)(2 * bp) * 256 + c) * L, o1 = seqoff + ((size_t)(2 * bp + 1) * 256 + c) * L;
  const u16* HG0 = (const u16*)(p.ws + OFF_HYIN);
  const u16* HG1 = HG0 + (size_t)TT * 256;
  const u16* HU = HG1 + (size_t)TT * 256;
  u16* HO = (u16*)(p.ws + OFF_HYO);
  const float2* HF = (const float2*)(p.ws + OFF_HF) + ((NJ == 16) ? 0 : (size_t)2 * 256 * 8192);
  float2 yr[NJ];
  __syncthreads();
#pragma unroll
  for (int j = 0; j < NJ; ++j) {
    const int t = tid + 256 * j;
    yr[j] = make_float2(bf2f(HU[o0 + t]), bf2f(HU[o1 + t]));
    buf[t] = yr[j];
    buf[L + t] = make_float2(0.f, 0.f);
  }
  __syncthreads();
#pragma unroll 1
  for (int o = 0; o < 2; ++o) {
    fft_fwd(buf, logn, TW);
    const float2* hf = HF + (size_t)(o * 256 + c) * N2;
    for (int i = tid; i < N2; i += 256) buf[i] = cmul(buf[i], hf[i]);
    __syncthreads();
    fft_inv(buf, logn, TW);
    const float bias = p.in[I_HYBIAS][(li * 2 + o) * 256 + c];
    const u16* HG = o ? HG1 : HG0;
#pragma unroll
    for (int j = 0; j < NJ; ++j) {
      const int t = tid + 256 * j;
      const float2 v = buf[t];
      yr[j].x = bf2f(HG[o0 + t]) * (v.x + yr[j].x * bias);
      yr[j].y = bf2f(HG[o1 + t]) * (v.y + yr[j].y * bias);
    }
    __syncthreads();
    if (o == 0) {
#pragma unroll
      for (int j = 0; j < NJ; ++j) { const int t = tid + 256 * j; buf[t] = yr[j]; buf[L + t] = make_float2(0.f, 0.f); }
      __syncthreads();
    } else {
#pragma unroll
      for (int j = 0; j < NJ; ++j) { const int t = tid + 256 * j; HO[o0 + t] = f2bf(yr[j].x); HO[o1 + t] = f2bf(yr[j].y); }
    }
  }
}

DEV void phaseC(const Params& p, int li, unsigned char* lds, int cidx = -1, int only = 0) {
  const bool need_ctx = (li == 0);
  const int n_scan = (only == 0 || only == 1) ? 96 : 0, n_attn = (only == 0 || only == 2) ? 768 : 0, n_fft = (only == 0 || only == 3) ? 1024 : 0, n_attc = (need_ctx && only == 0) ? 48 : 0, n_fftc = (need_ctx && only == 0) ? 1024 : 0;
  const int total = n_scan + n_attn + n_fft + n_attc + n_fftc;
  const float2* TWs = stage_tw(p, lds);
  unsigned* ctr = (unsigned*)(p.ws + OFF_CTR) + (cidx < 0 ? li : cidx);
  int* sitem = (int*)(lds + LDS_BYTES - 16);
  for (;;) {
    __syncthreads();
    if (threadIdx.x == 0) *sitem = (int)atomicAdd(ctr, 1u);
    __syncthreads();
    int r = *sitem;
    if (r >= total) break;
    if (r < n_scan) { scan_item(p, li, r, lds); continue; } r -= n_scan;
    if (r < n_attn) { const int bh = r >> 4, qt = r & 15; const int b = bh / 6, h = bh % 6; attn_item(p, b, h, qt * 256, 0, 68, b * 4096 + qt * 256, lds); continue; } r -= n_attn;
    if (r < n_fft) { hyfft_item<16>(p, li, r >> 2, r & 3, lds, TWs); continue; } r -= n_fft;
    if (r < n_attc) { const int bh = r; const int b = bh / 6, h = bh % 6; attn_item(p, b, h, 4096, 64, 68, TLAT + b * 256, lds); continue; } r -= n_attc;
    hyfft_item<1>(p, li, r >> 2, r & 3, lds, TWs);
  }
}

constexpr size_t OFF_MIX = OFF_QB;
DEV void phaseD0(const Params& p, int li) {
  const int tid = opaque_tid();
  const int ntok = (li == 0) ? TT : TLAT;
  const u16* Y0 = (const u16*)(p.ws + OFF_Y0);
  const u16* Y1 = (const u16*)(p.ws + OFF_Y1);
  const u16* G = (const u16*)(p.ws + OFF_G);
  const u16* BG = (const u16*)(p.ws + OFF_BG);
  const u16* ATT = (const u16*)(p.ws + OFF_ATT);
  const u16* HO = (const u16*)(p.ws + OFF_HYO);
  u16* MIX = (u16*)(p.ws + OFF_MIX);
  const float* gng = p.in[I_RWGNG] + li * 384;
  const float* gnb = p.in[I_RWGNB] + li * 384;
  for (int item = blockIdx.x; item < ntok / 32; item += gridDim.x) {
    const int tok = item * 32 + (tid >> 3), c8 = tid & 7;
#pragma unroll 2
    for (int kg = 0; kg < 16; ++kg) {
      const int k = kg * 64 + c8 * 8;
      uint4 o;
      if (kg < 6) {
        float a[8], bb[8], y[8];
        unpack8(*(const uint4*)(Y0 + (size_t)tok * 384 + k), a);
        unpack8(*(const uint4*)(Y1 + (size_t)tok * 384 + k), bb);
        float sm = 0.f;
#pragma unroll
        for (int j = 0; j < 8; ++j) { y[j] = a[j] + bb[j]; sm += y[j]; }
        sm = sum8(sm);
        const float mu = sm * (1.f / 64.f);
        float v = 0.f;
#pragma unroll
        for (int j = 0; j < 8; ++j) { y[j] -= mu; v += y[j] * y[j]; }
        v = sum8(v);
        const float rstd = rsqrtf(v * (1.f / 64.f) + 64e-5f);
        float g[8], bg[8];
        unpack8(*(const uint4*)(G + (size_t)tok * 384 + k), g);
        unpack8(*(const uint4*)(BG + (size_t)tok * 384 + k), bg);
#pragma unroll
        for (int j = 0; j < 8; ++j) y[j] = (y[j] * rstd * gng[k + j] + gnb[k + j]) * g[j] + bg[j];
        o = pack8(y);
      } else if (kg < 12) {
        o = *(const uint4*)(ATT + (size_t)tok * 384 + (k - 384));
      } else {
        const int ch = k - 768;
        const u16* src; int L;
        if (tok < TLAT) { L = 4096; src = HO + ((size_t)(tok >> 12) * 256 + ch) * 4096 + (tok & 4095); }
        else { L = 256; const int u = tok - TLAT; src = HO + (size_t)8 * 256 * 4096 + ((size_t)(u >> 8) * 256 + ch) * 256 + (u & 255); }
        o.x = (unsigned)src[0] | ((unsigned)src[(size_t)L] << 16);
        o.y = (unsigned)src[(size_t)2 * L] | ((unsigned)src[(size_t)3 * L] << 16);
        o.z = (unsigned)src[(size_t)4 * L] | ((unsigned)src[(size_t)5 * L] << 16);
        o.w = (unsigned)src[(size_t)6 * L] | ((unsigned)src[(size_t)7 * L] << 16);
      }
      *(uint4*)(MIX + (size_t)tok * 1024 + k) = o;
    }
  }
}
DEV void phaseD1(const Params& p, int li, unsigned char* lds) {
  const bool orig = (li == 0);
  const int nmt = (li == 0) ? 272 : 256;
  const u16* Wt = (const u16*)(p.ws + OFF_WOUT) + (size_t)li * 1024 * 1024;
  const u16* MIX = (const u16*)(p.ws + OFF_MIX);
  for (int item = blockIdx.x; item < nmt * 8; item += gridDim.x) {
    const int m0 = (item >> 3) * 128, n0 = (item & 7) * 128;
    gemm_tile<128, 128, 2, 2>(lds, 1024,
      [&](int row, int k) { return *(const uint4*)(MIX + (size_t)(m0 + row) * 1024 + k); },
      [&](int row, int k) { return *(const uint4*)(Wt + (size_t)(n0 + row) * 1024 + k); },
      [&](int mrow, int ncol, f32x4 a) {
        const int n = n0 + ncol;
#pragma unroll
        for (int r = 0; r < 4; ++r) {
          const int tok = m0 + mrow + r;
          const float gm = modp(p, li, tok_mv(tok), 2)[n];
          xdst(p, tok)[n] = xsrc(p, tok, orig)[n] + gm * a[r];
        }
      });
  }
}

constexpr size_t OFF_PUB = OFF_PRW;
typedef float f32x2v __attribute__((ext_vector_type(2)));
DEV unsigned pack_fp8x4(float a, float b, float c, float d) {
  int p = __builtin_amdgcn_cvt_pk_fp8_f32(a, b, 0, false);
  p = __builtin_amdgcn_cvt_pk_fp8_f32(c, d, p, true);
  return (unsigned)p;
}
DEV void unpack_fp8x4(unsigned v, float* f) {
  const f32x2v lo = __builtin_amdgcn_cvt_pk_f32_fp8((int)v, false), hi = __builtin_amdgcn_cvt_pk_f32_fp8((int)v, true);
  f[0] = lo.x; f[1] = lo.y; f[2] = hi.x; f[3] = hi.y;
}
constexpr float PEER_USCALE = 64.f, PEER_VSCALE = 4.f;
DEV void cvt_peer(const Params& p, int li) {
  const int tid = opaque_tid();
  const float* PU = p.in[I_PU] + (size_t)li * 16384 * 1024;
  const float* PV = p.in[I_PV] + (size_t)li * 16384 * 1024;
  unsigned char* dst = p.ws + OFF_PUB;
#pragma unroll 4
  for (int item = blockIdx.x; item < 16384; item += gridDim.x) {
    const bool isu = item < 8192;
    const float* src = isu ? PU + (size_t)item * 2048 : PV + (size_t)(item - 8192) * 2048;
    const float sc = isu ? PEER_USCALE : PEER_VSCALE;
    const float4 a = *(const float4*)(src + tid * 8), b = *(const float4*)(src + tid * 8 + 4);
    uint2 o;
    o.x = pack_fp8x4(a.x * sc, a.y * sc, a.z * sc, a.w * sc);
    o.y = pack_fp8x4(b.x * sc, b.y * sc, b.z * sc, b.w * sc);
    *(uint2*)(dst + (size_t)item * 2048 + tid * 8) = o;
  }
}

DEV unsigned fkey(float x) { const unsigned u = __float_as_uint(x); return (u & 0x80000000u) ? ~u : (u | 0x80000000u); }
DEV float funkey(unsigned k) { return __uint_as_float((k & 0x80000000u) ? (k ^ 0x80000000u) : ~k); }
DEV unsigned umax16(unsigned m) {
  m = max(m, (unsigned)dppi<0x128>((int)m)); m = max(m, (unsigned)dppi<0x124>((int)m));
  m = max(m, (unsigned)dppi<0x122>((int)m)); m = max(m, (unsigned)dppi<0x121>((int)m));
  return m;
}
DEV bool better(float v, int i, float ov, int oi) { return v > ov || (v == ov && i < oi); }
#define ARGMAX16_STEP(V, I, CTRL) { const float ov_ = dppf<CTRL>(V); const int oi_ = dppi<CTRL>(I); if (better(ov_, oi_, V, I)) { V = ov_; I = oi_; } }
#define ARGMAX16(V, I) ARGMAX16_STEP(V, I, 0x128) ARGMAX16_STEP(V, I, 0x124) ARGMAX16_STEP(V, I, 0x122) ARGMAX16_STEP(V, I, 0x121)
DEV void phaseD3(const Params& p, int li, unsigned char* lds) {
  const int nmt = (li == 0) ? 272 : 256;
  const u16* XN = (const u16*)(p.ws + OFF_XN);
  const int tid = opaque_tid(), lane = tid & 63, wave = tid >> 6;
  const int c = lane & 15, quad = lane >> 4, base = lane & 48;
  u16* Qs = (u16*)lds;
  u16* KS = (u16*)(lds + 67584);
  const float NEG = -3.0e38f;
  for (int item = blockIdx.x; item < nmt * 8; item += gridDim.x) {
    const int m0 = (item >> 3) * 128, h = item & 7;
    const u16* Wt = (const u16*)(p.ws + OFF_WQ) + ((size_t)li * 2048 + h * 256) * 1024;
    gemm_tile<128, 256, 1, 4>(lds, 1024,
      [&](int row, int k) { return *(const uint4*)(XN + (size_t)(m0 + row) * 1024 + k); },
      [&](int row, int k) { return *(const uint4*)(Wt + (size_t)row * 1024 + k); },
      [&](int mrow, int ncol, f32x4 a) {
#pragma unroll
        for (int r = 0; r < 4; ++r) Qs[(mrow + r) * 264 + ncol] = f2bf(a[r]);
      });
#pragma unroll 1
    for (int mt = 0; mt < 2; ++mt) {
    float sv[2][4]; int si[2][4];
#pragma unroll
    for (int pp = 0; pp < 2; ++pp) {
      const u16* keys = (const u16*)(p.ws + OFF_KEYS) + ((size_t)((li * 8 + h) * 2 + pp) * 128) * 128;
      f32x4 s[8];
#pragma unroll
      for (int j = 0; j < 8; ++j) s[j] = (f32x4){0.f, 0.f, 0.f, 0.f};
#pragma unroll
      for (int hf = 0; hf < 2; ++hf) {
        __syncthreads();
#pragma unroll
        for (int i = 0; i < 4; ++i) { const int id = tid + 256 * i; *(uint4*)(KS + (id >> 4) * 136 + (id & 15) * 8) = *(const uint4*)(keys + (size_t)(hf * 64 + (id >> 4)) * 128 + (id & 15) * 8); }
        __syncthreads();
#pragma unroll
        for (int ks = 0; ks < 4; ++ks) {
          const bf16x8 af = *(const bf16x8*)(Qs + (wave * 32 + mt * 16 + c) * 264 + pp * 128 + ks * 32 + quad * 8);
#pragma unroll
          for (int j = 0; j < 4; ++j) s[hf * 4 + j] = mfma16(af, *(const bf16x8*)(KS + (j * 16 + c) * 136 + ks * 32 + quad * 8), s[hf * 4 + j]);
        }
      }
      unsigned key[8][4];
#pragma unroll
      for (int j = 0; j < 8; ++j)
#pragma unroll
        for (int r = 0; r < 4; ++r) key[j][r] = (fkey(s[j][r]) & ~0x7Fu) | (unsigned)(127 - (j * 16 + c));
      unsigned kept[4] = {0u, 0u, 0u, 0u};
#pragma unroll 1
      for (int k = 0; k < 16; ++k) {
#pragma unroll
        for (int r = 0; r < 4; ++r) {
          unsigned m = max(max(max(key[0][r], key[1][r]), max(key[2][r], key[3][r])), max(max(key[4][r], key[5][r]), max(key[6][r], key[7][r])));
          m = umax16(m);
          if (c == k) kept[r] = m;
#pragma unroll
          for (int j = 0; j < 8; ++j) key[j][r] = (key[j][r] == m) ? 0u : key[j][r];
        }
      }
#pragma unroll
      for (int r = 0; r < 4; ++r) { sv[pp][r] = funkey(kept[r] & ~0x7Fu); si[pp][r] = 127 - (int)(kept[r] & 0x7Fu); }
    }
    int* EIDX = (int*)(p.ws + OFF_EIDX);
    float* GATE = (float*)(p.ws + OFF_GATE);
    unsigned ck[4][16];
#pragma unroll
    for (int r = 0; r < 4; ++r)
#pragma unroll
      for (int i = 0; i < 16; ++i) {
        const float a = __shfl(sv[0][r], base + i);
        ck[r][i] = ((i + 1) * (c + 1) <= 16) ? ((fkey(a + sv[1][r]) & ~0xFFu) | (unsigned)(255 - (i * 16 + c))) : 0u;
      }
    float tv[4]; int te[4];
#pragma unroll
    for (int r = 0; r < 4; ++r) { tv[r] = 0.f; te[r] = 0; }
#pragma unroll 1
    for (int k = 0; k < 16; ++k) {
#pragma unroll
      for (int r = 0; r < 4; ++r) {
        unsigned m = ck[r][0];
#pragma unroll
        for (int i = 1; i < 16; ++i) m = max(m, ck[r][i]);
        m = umax16(m);
        const int bf = 255 - (int)(m & 0xFFu);
        const int wi = bf >> 4, wj = bf & 15;
        const int e0 = __shfl(si[0][r], base + wi), e1 = __shfl(si[1][r], base + wj);
        if (c == k) { tv[r] = funkey(m & ~0xFFu); te[r] = e0 * 128 + e1; }
#pragma unroll
        for (int i = 0; i < 16; ++i) ck[r][i] = (ck[r][i] == m) ? 0u : ck[r][i];
      }
    }
#pragma unroll
    for (int r = 0; r < 4; ++r) {
      const float mx = __shfl(tv[r], base);
      const float e = __expf(tv[r] - mx);
      const float sum = sum16(e);
      const int tok = m0 + wave * 32 + mt * 16 + quad * 4 + r;
      EIDX[(size_t)tok * 128 + h * 16 + c] = te[r];
      GATE[(size_t)tok * 128 + h * 16 + c] = e / sum;
    }
    }
  }
}

template <bool DRY>
DEV void phaseD4(const Params& p, int li, unsigned char* lds) {
  const int ntok = (li == 0) ? TT : TLAT;
  const int tid_ = opaque_tid(); const int lane = tid_ & 63, wave = tid_ >> 6;
  const unsigned char* PUb = p.ws + OFF_PUB;
  const unsigned char* PVb = PUb + (size_t)16384 * 1024;
  u16* XN = (u16*)(p.ws + OFF_XN);
  for (int item = blockIdx.x; item < ntok / 4; item += gridDim.x) {
    const int tok = item * 4 + wave;
    f32x2 hv2[8];
    {
      const uint4 h0 = *(const uint4*)(XN + (size_t)tok * 1024 + lane * 16), h1 = *(const uint4*)(XN + (size_t)tok * 1024 + lane * 16 + 8);
      float hv[16];
      unpack8(h0, hv); unpack8(h1, hv + 8);
#pragma unroll
      for (int j = 0; j < 8; ++j) hv2[j] = (f32x2){hv[2 * j], hv[2 * j + 1]};
    }
    const int* EI = (const int*)(p.ws + OFF_EIDX) + (size_t)tok * 128;
    const float* GT = (const float*)(p.ws + OFF_GATE) + (size_t)tok * 128;
    const int ei0 = EI[lane], ei1 = EI[64 + lane];
    const float g0 = GT[lane], g1 = GT[64 + lane];
    f32x2 out2[8];
#pragma unroll
    for (int j = 0; j < 8; ++j) out2[j] = (f32x2){0.f, 0.f};
    uint4 ua[8], va[8];
    int e[8]; float gg[8];
#pragma unroll
    for (int u = 0; u < 8; ++u) { e[u] = __shfl(ei0, u); gg[u] = __shfl(g0, u); }
#pragma unroll
    for (int u = 0; u < 8; ++u) { ua[u] = *(const uint4*)(PUb + (size_t)e[u] * 1024 + lane * 16); }
#pragma unroll 1
    for (int i = 0; i < 128; i += 8) {
      float dot[8];
#pragma unroll
      for (int u = 0; u < 8; ++u) { va[u] = *(const uint4*)(PVb + (size_t)e[u] * 1024 + lane * 16); }
#pragma unroll
      for (int u = 0; u < 8; ++u) {
        const unsigned uw[4] = {ua[u].x, ua[u].y, ua[u].z, ua[u].w};
        f32x2 da = (f32x2){0.f, 0.f}, db = da;
#pragma unroll
        for (int q4 = 0; q4 < 4; ++q4) {
          da += __builtin_amdgcn_cvt_pk_f32_fp8((int)uw[q4], false) * hv2[2 * q4];
          db += __builtin_amdgcn_cvt_pk_f32_fp8((int)uw[q4], true) * hv2[2 * q4 + 1];
        }
        da += db;
        dot[u] = (da.x + da.y) * (1.f / PEER_USCALE);
      }
      float gcur[8];
#pragma unroll
      for (int u = 0; u < 8; ++u) gcur[u] = gg[u];
      if (i + 8 < 128) {
#pragma unroll
        for (int u = 0; u < 8; ++u) {
          const int ii = i + 8 + u;
          e[u] = (ii < 64) ? __shfl(ei0, ii) : __shfl(ei1, ii - 64);
          gg[u] = (ii < 64) ? __shfl(g0, ii) : __shfl(g1, ii - 64);
        }
#pragma unroll
        for (int u = 0; u < 8; ++u) { ua[u] = *(const uint4*)(PUb + (size_t)e[u] * 1024 + lane * 16); }
      }
#pragma unroll
      for (int u = 0; u < 8; ++u) dot[u] = wave_sum(dot[u]);
      {
        float mine = dot[0];
#pragma unroll
        for (int u = 1; u < 8; ++u) mine = ((lane & 7) == u) ? dot[u] : mine;
        const float act = 0.5f * mine * (1.f + erff(mine * 0.70710678118654752f));
#pragma unroll
        for (int u = 0; u < 8; ++u) dot[u] = __int_as_float(__builtin_amdgcn_readlane(__float_as_int(act), u)) * gcur[u] * (1.f / PEER_VSCALE);
      }
#pragma unroll
      for (int u = 0; u < 8; ++u) {
        const unsigned vw[4] = {va[u].x, va[u].y, va[u].z, va[u].w};
        const f32x2 a2 = (f32x2){dot[u], dot[u]};
#pragma unroll
        for (int q4 = 0; q4 < 4; ++q4) {
          out2[2 * q4] += a2 * __builtin_amdgcn_cvt_pk_f32_fp8((int)vw[q4], false);
          out2[2 * q4 + 1] += a2 * __builtin_amdgcn_cvt_pk_f32_fp8((int)vw[q4], true);
        }
      }
    }
    float out[16];
#pragma unroll
    for (int j = 0; j < 8; ++j) { out[2 * j] = out2[j].x; out[2 * j + 1] = out2[j].y; }
    const int mv = tok_mv(tok);
    const float* gf = modp(p, li, mv, 5) + lane * 16;
    float* xr = xdst(p, tok) + lane * 16;
    float xv[16]; float ss = 0.f;
#pragma unroll
    for (int j = 0; j < 4; ++j) {
      float4 x = *(const float4*)(xr + j * 4);
      const float4 g = *(const float4*)(gf + j * 4);
      x.x += g.x * out[j * 4]; x.y += g.y * out[j * 4 + 1]; x.z += g.z * out[j * 4 + 2]; x.w += g.w * out[j * 4 + 3];
      if (!DRY) *(float4*)(xr + j * 4) = x;
      xv[j * 4] = x.x; xv[j * 4 + 1] = x.y; xv[j * 4 + 2] = x.z; xv[j * 4 + 3] = x.w;
      ss += x.x * x.x + x.y * x.y + x.z * x.z + x.w * x.w;
    }
    if (DRY) { if (lane == 0) ((float*)(p.ws + OFF_G))[tok] = ss; }
    else if (li == 0) {
      ss = wave_sum(ss);
      const float rstd = rsqrtf(ss * (1.f / 1024.f) + 1e-6f);
      const float* gain = p.in[I_MIXNORM] + 1024 + lane * 16;
      const float* sc = modp(p, 1, mv, 1) + lane * 16;
      const float* sh = modp(p, 1, mv, 0) + lane * 16;
      float o[16];
#pragma unroll
      for (int j = 0; j < 16; ++j) o[j] = xv[j] * rstd * gain[j] * (1.f + sc[j]) + sh[j];
      *(uint4*)(XN + (size_t)tok * 1024 + lane * 16) = pack8(o);
      *(uint4*)(XN + (size_t)tok * 1024 + lane * 16 + 8) = pack8(o + 8);
    }
  }
}

DEV void dump_bf(const Params& p, size_t o0, size_t n0, size_t o1, size_t n1, size_t o2, size_t n2, size_t o3, size_t n3) {
  const size_t Q = 8388608;
  for (size_t i = (size_t)blockIdx.x * 256 + threadIdx.x; i < 4 * Q; i += (size_t)gridDim.x * 256) {
    const int q = (int)(i / Q); const size_t j = i % Q;
    const size_t off = q == 0 ? o0 : q == 1 ? o1 : q == 2 ? o2 : o3;
    const size_t n = q == 0 ? n0 : q == 1 ? n1 : q == 2 ? n2 : n3;
    const size_t stride = (DIAG == 15) ? (n / Q > 2 ? n / Q : 2) : (n / Q > 0 ? n / Q : 1);
    const size_t idx = j * stride;
    p.out[i] = idx < n ? bf2f(((const u16*)(p.ws + off))[idx]) : 0.f;
  }
}
DEV void grid_barrier(const Params& p, int k) {
  asm volatile("s_waitcnt vmcnt(0)" ::: "memory");
  if (k == 0 || (gridDim.x & 7) != 0) {
    cg::this_grid().sync();
  } else {
    __syncthreads();
    if (threadIdx.x == 0) {
      unsigned* bar = (unsigned*)(p.ws + OFF_BAR);
      const unsigned gsz = gridDim.x >> 3, g = blockIdx.x & 7;
      __builtin_amdgcn_fence(__ATOMIC_RELEASE, "agent");
      const unsigned old = __hip_atomic_fetch_add(bar + g * 64, 1u, __ATOMIC_RELAXED, __HIP_MEMORY_SCOPE_AGENT);
      if (old == (unsigned)k * gsz - 1u) __hip_atomic_fetch_add(bar + 8 * 64, 1u, __ATOMIC_RELAXED, __HIP_MEMORY_SCOPE_AGENT);
      while (__hip_atomic_load(bar + 8 * 64, __ATOMIC_RELAXED, __HIP_MEMORY_SCOPE_AGENT) < (unsigned)k * 8u) __builtin_amdgcn_s_sleep(1);
    }
    __syncthreads();
  }
  __builtin_amdgcn_fence(__ATOMIC_ACQUIRE, "agent");
}
#define PH(K, CALL) if (ph_lo <= (K) && (K) < ph_hi) { CALL; if ((K) + 1 < ph_hi) grid_barrier(p, bar_k++); }
__global__ void __launch_bounds__(256, 1) mega(Params p, int ph_lo, int ph_hi) {
  __shared__ __attribute__((aligned(16))) unsigned char lds[LDS_BYTES];
  int bar_k = 0;
#if DIAG == 9
  { uint4* q = (uint4*)(p.ws + OFF_XCTX); const size_t n = (WS_END - OFF_XCTX) / 16;
    for (size_t i = (size_t)blockIdx.x * 256 + threadIdx.x; i < n; i += (size_t)gridDim.x * 256) q[i] = make_uint4(0xAAAAAAAAu, 0xAAAAAAAAu, 0xAAAAAAAAu, 0xAAAAAAAAu);
    cg::this_grid().sync(); }
#endif
  PH(0, phase0a(p, lds))
  PH(1, norm_pass(p, 0, true, p.in[I_MIXNORM], 1, 0, TT))
#if PROBE_AB == 1
  PH(2, (phaseA(p, 0, lds), phaseA(p, 0, lds)))
#else
  PH(2, phaseA(p, 0, lds))
#endif
#if PROBE_AB == 2
  PH(3, (phaseB(p, 0, lds), phaseB(p, 0, lds)))
#else
  PH(3, phaseB(p, 0, lds))
#endif
#if DIAG == 1
  PH(4, dump_bf(p, OFF_QB, 53477376ull, OFF_HYIN, 26738688ull, OFF_G, 26738688ull, OFF_PRW, 49020928ull))
#elif DIAG == 15
  PH(4, dump_bf(p, OFF_HF + 2, 17825790ull, OFF_TW + 2, 16382ull, OFF_H2 + 2, 1114110ull, OFF_ATT, 0ull))
#elif DIAG == 11
  PH(4, dump_bf(p, OFF_PRW + 2 * (49020928ull - 8388608ull), 8388608ull, OFF_PMH + 2 * (41222144ull - 8388608ull), 8388608ull, OFF_QB + 2 * (53477376ull - 8388608ull), 8388608ull, OFF_G + 2 * (26738688ull - 8388608ull), 8388608ull))
#elif DIAG == 2
  PH(4, dump_bf(p, OFF_PRW, 49020928ull, OFF_PMH, 41222144ull, OFF_XN, 35651584ull, OFF_WIN, 5505024ull))
#else
#if PROBE_C
  PH(4, (phaseC(p, 0, lds, 2, PROBE_C), phaseC(p, 0, lds)))
#else
  PH(4, phaseC(p, 0, lds))
#endif
#endif
#if DIAG == 3
  PH(5, dump_bf(p, OFF_ATT, 13369344ull, OFF_HYO, 8912896ull, OFF_Y0, 13369344ull, OFF_Y1, 13369344ull))
#elif DIAG == 12
  PH(5, dump_bf(p, OFF_ATT + 2 * 8388608ull, 4980736ull, OFF_ATT, 0ull, OFF_ATT, 0ull, OFF_ATT, 0ull))
#elif DIAG == 13
  PH(5, dump_bf(p, OFF_Y0 + 2 * 8388608ull, 4980736ull, OFF_Y1 + 2 * 8388608ull, 4980736ull, OFF_ATT, 0ull, OFF_ATT, 0ull))
#elif DIAG == 14
  PH(5, dump_bf(p, OFF_HYO, 8388608ull, OFF_HYO + 2 * 8388608ull, 524288ull, OFF_ATT, 0ull, OFF_ATT, 0ull))
#elif DIAG == 10
  PH(5, dump_bf(p, OFF_ATT + 2 * 4980736ull, 8388608ull, OFF_HYO + 2 * 524288ull, 8388608ull, OFF_Y0 + 2 * 4980736ull, 8388608ull, OFF_Y1 + 2 * 4980736ull, 8388608ull))
#else
#if PROBE_AB == 3
  PH(5, (phaseD1(p, 0, lds), phaseD1(p, 0, lds)))
#else
  PH(5, (phaseD0(p, 0), grid_barrier(p, bar_k++), phaseD1(p, 0, lds)))
#endif
#endif
  PH(6, (norm_pass(p, 0, false, p.in[I_FFNNORM], 4, 3, TT), cvt_peer(p, 0)))
#if PROBE_D3
  PH(7, (phaseD3(p, 0, lds), phaseD3(p, 0, lds)))
#else
  PH(7, phaseD3(p, 0, lds))
#endif
#if PROBE_D4
  PH(8, (phaseD4<true>(p, 0, lds), phaseD4<false>(p, 0, lds)))
#else
  PH(8, phaseD4<false>(p, 0, lds))
#endif
  PH(9, phaseA(p, 1, lds))
  PH(10, phaseB(p, 1, lds))
  PH(11, phaseC(p, 1, lds))
  PH(12, (phaseD0(p, 1), grid_barrier(p, bar_k++), phaseD1(p, 1, lds)))
  PH(13, (norm_pass(p, 1, false, p.in[I_FFNNORM] + 1024, 4, 3, TLAT), cvt_peer(p, 1)))
  PH(14, phaseD3(p, 1, lds))
  PH(15, phaseD4<false>(p, 1, lds))
}

extern "C" void kernel_launch(void* const* d_in, const int* in_sizes, int n_in, void* d_out, int out_size, void* d_ws, size_t ws_size, hipStream_t stream) {
  static int grid_blocks = 0;
  if (!grid_blocks) {
    int dev = 0, cus = 0, per_cu = 0;
    hipGetDevice(&dev);
    hipDeviceGetAttribute(&cus, hipDeviceAttributeMultiprocessorCount, dev);
    hipOccupancyMaxActiveBlocksPerMultiprocessor(&per_cu, mega, 256, 0);
    if (per_cu > GRID_BLOCKS_PER_CU) per_cu = GRID_BLOCKS_PER_CU;
    if (per_cu < 1) per_cu = 1;
    grid_blocks = cus * per_cu;
  }
  if (n_in != N_IN || ws_size < WS_NEED) { fprintf(stderr, "kernel_launch: bad inputs n_in=%d ws=%zu need %zu\n", n_in, ws_size, (size_t)WS_NEED); return; }
  Params p{};
  for (int i = 0; i < N_IN; ++i) p.in[i] = (const float*)d_in[i];
  p.out = (float*)d_out; p.ws = (unsigned char*)d_ws;
#if MULTI_LAUNCH
  for (int ph = 0; ph < NPH; ++ph) hipLaunchKernelGGL(mega, dim3(grid_blocks), dim3(256), 0, stream, p, ph, ph + 1);
#else
  int lo = 0, hi = NPH;
  void* args[] = {&p, &lo, &hi};
  hipError_t e = hipLaunchCooperativeKernel((void*)mega, dim3(grid_blocks), dim3(256), args, 0, stream);
  if (e != hipSuccess) fprintf(stderr, "cooperative launch failed: %s (grid %d)\n", hipGetErrorString(e), grid_blocks);
#endif
}
```

```cpp
#include <hip/hip_runtime.h>
#include <hip/hip_cooperative_groups.h>
#include <cstdio>
namespace cg = cooperative_groups;

#ifndef DIAG
#define DIAG 0
#endif
#ifndef PROBE_D4
#define PROBE_D4 0
#endif
#ifndef PROBE_D3
#define PROBE_D3 0
#endif
#ifndef PROBE_AB
#define PROBE_AB 0
#endif
#ifndef PROBE_C
#define PROBE_C 0
#endif
#ifndef MULTI_LAUNCH
#define MULTI_LAUNCH 0
#endif

typedef unsigned short u16;
typedef __attribute__((ext_vector_type(8))) short bf16x8;
typedef __attribute__((ext_vector_type(4))) float f32x4;
typedef __attribute__((ext_vector_type(2))) float f32x2;
#define DEV __device__ __forceinline__

constexpr int D = 1024, TLAT = 32768, TCTX = 2048, TT = 34816, KTOT = 4352;
constexpr int NPH = 16;
constexpr int LDS_BYTES = 98304 + 256;
constexpr int GRID_BLOCKS_PER_CU = 2;

enum { I_X = 0, I_C, I_CTX, I_CCTX, I_MODW, I_MODB, I_MIXNORM, I_WIN, I_WOUT, I_RWCONV, I_RWDUP, I_RWD0, I_RWAUP, I_RWA0,
       I_RWGUP, I_RWKK, I_RWKA, I_RWRK, I_RWGNG, I_RWGNB, I_MQNORM, I_MWUQ, I_MKVNORM, I_MWUKV, I_MQGAIN, I_MKGAIN,
       I_HYCONV, I_HYW1, I_HYB1, I_HYF1, I_HYW2, I_HYB2, I_HYF2, I_HYW3, I_HYB3, I_HYBIAS, I_FFNNORM, I_PWQ, I_PKEYS, I_PU, I_PV, N_IN };

struct Params { const float* in[N_IN]; float* out; unsigned char* ws; };

constexpr size_t OFF_CTR  = 0;
constexpr size_t OFF_WIN  = 256;
constexpr size_t OFF_WOUT = OFF_WIN  + 2ull * 2688 * 1024 * 2;
constexpr size_t OFF_WQ   = OFF_WOUT + 2ull * 1024 * 1024 * 2;
constexpr size_t OFF_WUQ  = OFF_WQ   + 2ull * 2048 * 1024 * 2;
constexpr size_t OFF_WUKV = OFF_WUQ  + 2ull * 576 * 256 * 2;
constexpr size_t OFF_DUT  = OFF_WUKV + 2ull * 768 * 128 * 2;
constexpr size_t OFF_AUT  = OFF_DUT  + 4ull * 384 * 64 * 2;
constexpr size_t OFF_GUT  = OFF_AUT  + 4ull * 384 * 64 * 2;
constexpr size_t OFF_KEYS = OFF_GUT  + 2ull * 384 * 128 * 2;
constexpr size_t OFF_MOD  = OFF_KEYS + 2ull * 8 * 2 * 128 * 128 * 2;
constexpr size_t OFF_H2   = OFF_MOD  + 2ull * 9 * 6144 * 4;
constexpr size_t OFF_TW   = OFF_H2   + 2ull * 4352 * 64 * 4;
constexpr size_t OFF_ROPE = OFF_TW   + 4096ull * 8;
constexpr size_t OFF_HF   = OFF_ROPE + 2ull * 4096 * 16 * 4;
constexpr size_t OFF_XCTX = OFF_HF   + 2ull * 256 * 8192 * 8 + 2ull * 256 * 512 * 8;
constexpr size_t OFF_PRW  = OFF_XCTX + 2048ull * 1024 * 4;
constexpr size_t OFF_PMH  = OFF_PRW  + (size_t)TT * 1408 * 2;
constexpr size_t OFF_ATT  = OFF_PMH;
constexpr size_t OFF_HYO  = OFF_ATT  + (size_t)TT * 384 * 2;
constexpr size_t OFF_Y0   = OFF_HYO  + (size_t)TT * 256 * 2;
constexpr size_t OFF_QB   = OFF_PMH  + (size_t)TT * 1184 * 2;
constexpr size_t OFF_KB   = OFF_QB   + 48ull * KTOT * 96 * 2;
constexpr size_t OFF_VT   = OFF_KB   + 48ull * KTOT * 96 * 2;
constexpr size_t OFF_XN   = OFF_QB;
constexpr size_t OFF_EIDX = OFF_XN   + (size_t)TT * 1024 * 2;
constexpr size_t OFF_GATE = OFF_EIDX + (size_t)TT * 128 * 4;
constexpr size_t OFF_HYIN = OFF_VT   + 48ull * 64 * KTOT * 2;
constexpr size_t OFF_G    = OFF_HYIN + 3ull * TT * 256 * 2;
constexpr size_t OFF_BG   = OFF_G    + (size_t)TT * 384 * 2;
constexpr size_t OFF_Y1   = OFF_BG   + (size_t)TT * 384 * 2;
constexpr size_t WS_END   = OFF_Y1   + (size_t)TT * 384 * 2;
static_assert(OFF_GATE + (size_t)TT * 128 * 4 <= OFF_HYIN, "alias overflow");
static_assert(OFF_Y0 + (size_t)TT * 384 * 2 <= OFF_QB, "alias overflow 2");
constexpr size_t OFF_BAR = WS_END;
constexpr size_t WS_NEED = WS_END + 4096;
static_assert(WS_NEED <= 536870912ull, "workspace too large");

DEV u16 f2bf(float f) { unsigned r; asm("v_cvt_pk_bf16_f32 %0, %1, %1" : "=v"(r) : "v"(f)); return (u16)(r & 0xffffu); }
DEV float bf2f(u16 h) { return __uint_as_float(((unsigned)h) << 16); }
DEV unsigned pack2(float a, float b) { unsigned r; asm("v_cvt_pk_bf16_f32 %0, %1, %2" : "=v"(r) : "v"(a), "v"(b)); return r; }
DEV float lo2f(unsigned u) { return __uint_as_float(u << 16); }
DEV float hi2f(unsigned u) { return __uint_as_float(u & 0xffff0000u); }
DEV uint4 pack8(const float* f) { uint4 r; r.x = pack2(f[0], f[1]); r.y = pack2(f[2], f[3]); r.z = pack2(f[4], f[5]); r.w = pack2(f[6], f[7]); return r; }
DEV void unpack8(uint4 v, float* f) { f[0] = lo2f(v.x); f[1] = hi2f(v.x); f[2] = lo2f(v.y); f[3] = hi2f(v.y); f[4] = lo2f(v.z); f[5] = hi2f(v.z); f[6] = lo2f(v.w); f[7] = hi2f(v.w); }
DEV float sigmoidf_(float x) { return 1.f / (1.f + __expf(-x)); }

template <int CTRL> DEV float dppf(float x) { return __int_as_float(__builtin_amdgcn_update_dpp(0, __float_as_int(x), CTRL, 0xf, 0xf, false)); }
template <int CTRL> DEV int dppi(int x) { return __builtin_amdgcn_update_dpp(0, x, CTRL, 0xf, 0xf, false); }
DEV float sum4(float v) { v += dppf<0xB1>(v); v += dppf<0x4E>(v); return v; }
DEV float sum8(float v) { v = sum4(v); v += dppf<0x141>(v); return v; }
DEV float sum16(float v) { v = sum8(v); v += dppf<0x140>(v); return v; }
DEV float wave_sum(float v) { v = sum16(v); v += __shfl_xor(v, 16); v += __shfl_xor(v, 32); return v; }
DEV bf16x8 as_bf8(uint4 v) { union { uint4 u; bf16x8 b; } x; x.u = v; return x.b; }
DEV f32x4 mfma16(bf16x8 a, bf16x8 b, f32x4 c) { return __builtin_amdgcn_mfma_f32_16x16x32_bf16(a, b, c, 0, 0, 0); }
DEV float dot2bf(unsigned a, unsigned b, float c) { asm("v_dot2c_f32_bf16 %0, %1, %2" : "+v"(c) : "v"(a), "v"(b)); return c; }
DEV float fsin(float x) { return __builtin_amdgcn_sinf(x * 0.15915494309189535f); }
DEV float fcos(float x) { return __builtin_amdgcn_cosf(x * 0.15915494309189535f); }

DEV int opaque_tid() { int t = threadIdx.x; asm volatile("" : "+v"(t)); return t; }
DEV int tok_mv(int tok) { return tok < TLAT ? (tok >> 12) : 8; }
DEV const float* xsrc(const Params& p, int tok, bool orig) {
  if (tok < TLAT) return (orig ? p.in[I_X] : p.out) + (size_t)tok * D;
  return (orig ? p.in[I_CTX] : (const float*)(p.ws + OFF_XCTX)) + (size_t)(tok - TLAT) * D;
}
DEV float* xdst(const Params& p, int tok) {
  if (tok < TLAT) return p.out + (size_t)tok * D;
  return (float*)(p.ws + OFF_XCTX) + (size_t)(tok - TLAT) * D;
}
DEV const float* modp(const Params& p, int li, int mv, int chunk) { return (const float*)(p.ws + OFF_MOD) + ((size_t)(li * 9 + mv) * 6 + chunk) * 1024; }

DEV void conv8(const u16* P, int ld, int tok, bool hp, bool hn, int col, const float* cw, int cwld, float* out) {
  const u16* r = P + (size_t)tok * ld + col;
  uint4 z = make_uint4(0, 0, 0, 0);
  uint4 v1 = *(const uint4*)r;
  uint4 v0 = hp ? *(const uint4*)(r - ld) : z;
  uint4 v2 = hn ? *(const uint4*)(r + ld) : z;
  float a[8], b[8], c[8];
  unpack8(v0, a); unpack8(v1, b); unpack8(v2, c);
  float4 w0a = *(const float4*)(cw), w0b = *(const float4*)(cw + 4);
  float4 w1a = *(const float4*)(cw + cwld), w1b = *(const float4*)(cw + cwld + 4);
  float4 w2a = *(const float4*)(cw + 2 * cwld), w2b = *(const float4*)(cw + 2 * cwld + 4);
  const float w0[8] = {w0a.x, w0a.y, w0a.z, w0a.w, w0b.x, w0b.y, w0b.z, w0b.w};
  const float w1[8] = {w1a.x, w1a.y, w1a.z, w1a.w, w1b.x, w1b.y, w1b.z, w1b.w};
  const float w2[8] = {w2a.x, w2a.y, w2a.z, w2a.w, w2b.x, w2b.y, w2b.z, w2b.w};
#pragma unroll
  for (int j = 0; j < 8; ++j) out[j] = a[j] * w0[j] + b[j] * w1[j] + c[j] * w2[j];
}
DEV void tok_nb(int tok, bool& hp, bool& hn) {
  if (tok < TLAT) { int t = tok & 4095; hp = t > 0; hn = t < 4095; }
  else { int t = (tok - TLAT) & 255; hp = t > 0; hn = t < 255; }
}

template <int BM, int BN, int WM, int WN, class AL, class BL, class EP>
DEV void gemm_tile(unsigned char* lds, int K, AL aload, BL bload, EP epi) {
  constexpr int LDT = 72;
  constexpr int TM = BM / WM / 16, TN = BN / WN / 16;
  constexpr int NA = BM * 8 / 256, NBc = BN * 8 / 256;
  u16* As = (u16*)lds;
  u16* Bs = As + BM * LDT;
  const int tid = opaque_tid(), lane = tid & 63, wave = tid >> 6;
  const int wm = wave / WN, wn = wave % WN;
  const int c = lane & 15, quad = lane >> 4;
  f32x4 acc[TM][TN];
#pragma unroll
  for (int i = 0; i < TM; ++i)
#pragma unroll
    for (int j = 0; j < TN; ++j) acc[i][j] = (f32x4){0.f, 0.f, 0.f, 0.f};
  uint4 ra[NA], rb[NBc];
#pragma unroll
  for (int i = 0; i < NA; ++i) { int id = tid + 256 * i; ra[i] = aload(id >> 3, (id & 7) * 8); }
#pragma unroll
  for (int i = 0; i < NBc; ++i) { int id = tid + 256 * i; rb[i] = bload(id >> 3, (id & 7) * 8); }
  const int nk = K / 64;
  for (int kt = 0; kt < nk; ++kt) {
    __syncthreads();
#pragma unroll
    for (int i = 0; i < NA; ++i) { int id = tid + 256 * i; *(uint4*)(As + (id >> 3) * LDT + (id & 7) * 8) = ra[i]; }
#pragma unroll
    for (int i = 0; i < NBc; ++i) { int id = tid + 256 * i; *(uint4*)(Bs + (id >> 3) * LDT + (id & 7) * 8) = rb[i]; }
    __syncthreads();
    if (kt + 1 < nk) {
      const int k0 = (kt + 1) * 64;
#pragma unroll
      for (int i = 0; i < NA; ++i) { int id = tid + 256 * i; ra[i] = aload(id >> 3, k0 + (id & 7) * 8); }
#pragma unroll
      for (int i = 0; i < NBc; ++i) { int id = tid + 256 * i; rb[i] = bload(id >> 3, k0 + (id & 7) * 8); }
    }
#pragma unroll (TN >= 8 ? 1 : 2)
    for (int ks = 0; ks < 2; ++ks) {
      bf16x8 af[TM], bfr[TN];
#pragma unroll
      for (int i = 0; i < TM; ++i) af[i] = *(const bf16x8*)(As + (wm * (BM / WM) + i * 16 + c) * LDT + ks * 32 + quad * 8);
#pragma unroll
      for (int j = 0; j < TN; ++j) bfr[j] = *(const bf16x8*)(Bs + (wn * (BN / WN) + j * 16 + c) * LDT + ks * 32 + quad * 8);
#pragma unroll
      for (int i = 0; i < TM; ++i)
#pragma unroll
        for (int j = 0; j < TN; ++j) acc[i][j] = mfma16(af[i], bfr[j], acc[i][j]);
    }
  }
  __syncthreads();
#pragma unroll
  for (int i = 0; i < TM; ++i)
#pragma unroll
    for (int j = 0; j < TN; ++j) epi(wm * (BM / WM) + i * 16 + quad * 4, wn * (BN / WN) + j * 16 + c, acc[i][j]);
}

DEV void transpose_item(const float* W, int K, int N, u16* Wt, int item, unsigned char* lds, int ntn) {
  float* tile = (float*)lds;
  const int kb = item / ntn, nb = item % ntn;
  const int tid = opaque_tid();
  __syncthreads();
#pragma unroll
  for (int i = 0; i < 16; ++i) {
    int kk = i * 4 + (tid >> 6), nn = tid & 63;
    int n = nb * 64 + nn;
    tile[kk * 65 + nn] = (n < N) ? W[(size_t)(kb * 64 + kk) * N + n] : 0.f;
  }
  __syncthreads();
  const int nl = tid >> 2, kq = tid & 3;
  float f[16];
#pragma unroll
  for (int j = 0; j < 16; ++j) f[j] = tile[(kq * 16 + j) * 65 + nl];
  u16* dst = Wt + (size_t)(nb * 64 + nl) * K + kb * 64 + kq * 16;
  *(uint4*)dst = pack8(f);
  *(uint4*)(dst + 8) = pack8(f + 8);
}

DEV void phase0a(const Params& p, unsigned char* lds) {
  const int tid = opaque_tid();
  if (blockIdx.x == 0 && tid < 64) ((unsigned*)(p.ws + OFF_CTR))[tid] = 0u;
  if (blockIdx.x == 0) { for (int i = tid; i < 1024; i += 256) ((unsigned*)(p.ws + OFF_BAR))[i] = 0u; }
  constexpr int J_WIN = 2 * 16 * 42, J_WOUT = 2 * 16 * 16, J_WQ = 2 * 16 * 32, J_WUQ = 2 * 4 * 9, J_WUKV = 2 * 2 * 12,
                J_DU = 4 * 6, J_AU = 4 * 6, J_GU = 2 * 2 * 6, J_KEYS = 256, J_MOD = 192, J_H2 = 2176, J_TW = 16, J_ROPE = 256;
  constexpr int TOTAL = J_WIN + J_WOUT + J_WQ + J_WUQ + J_WUKV + J_DU + J_AU + J_GU + J_KEYS + J_MOD + J_H2 + J_TW + J_ROPE;
  for (int item = blockIdx.x; item < TOTAL; item += gridDim.x) {
    int r = item;
    if (r < J_WIN) { int li = r / 672; r %= 672; transpose_item(p.in[I_WIN] + (size_t)li * 1024 * 2592, 1024, 2592, (u16*)(p.ws + OFF_WIN) + (size_t)li * 2688 * 1024, r, lds, 42); continue; } r -= J_WIN;
    if (r < J_WOUT) { int li = r / 256; r %= 256; transpose_item(p.in[I_WOUT] + (size_t)li * 1024 * 1024, 1024, 1024, (u16*)(p.ws + OFF_WOUT) + (size_t)li * 1024 * 1024, r, lds, 16); continue; } r -= J_WOUT;
    if (r < J_WQ) { int li = r / 512; r %= 512; transpose_item(p.in[I_PWQ] + (size_t)li * 1024 * 2048, 1024, 2048, (u16*)(p.ws + OFF_WQ) + (size_t)li * 2048 * 1024, r, lds, 32); continue; } r -= J_WQ;
    if (r < J_WUQ) { int li = r / 36; r %= 36; transpose_item(p.in[I_MWUQ] + (size_t)li * 256 * 576, 256, 576, (u16*)(p.ws + OFF_WUQ) + (size_t)li * 576 * 256, r, lds, 9); continue; } r -= J_WUQ;
    if (r < J_WUKV) { int li = r / 24; r %= 24; transpose_item(p.in[I_MWUKV] + (size_t)li * 128 * 768, 128, 768, (u16*)(p.ws + OFF_WUKV) + (size_t)li * 768 * 128, r, lds, 12); continue; } r -= J_WUKV;
    if (r < J_DU) { int m = r / 6; r %= 6; transpose_item(p.in[I_RWDUP] + (size_t)m * 64 * 384, 64, 384, (u16*)(p.ws + OFF_DUT) + (size_t)m * 384 * 64, r, lds, 6); continue; } r -= J_DU;
    if (r < J_AU) { int m = r / 6; r %= 6; transpose_item(p.in[I_RWAUP] + (size_t)m * 64 * 384, 64, 384, (u16*)(p.ws + OFF_AUT) + (size_t)m * 384 * 64, r, lds, 6); continue; } r -= J_AU;
    if (r < J_GU) { int li = r / 12; r %= 12; transpose_item(p.in[I_RWGUP] + (size_t)li * 128 * 384, 128, 384, (u16*)(p.ws + OFF_GUT) + (size_t)li * 384 * 128, r, lds, 6); continue; } r -= J_GU;
    if (r < J_KEYS) {
      const float* src = p.in[I_PKEYS] + (size_t)r * 2048 + tid * 8;
      float4 a = *(const float4*)src, b = *(const float4*)(src + 4);
      float f[8] = {a.x, a.y, a.z, a.w, b.x, b.y, b.z, b.w};
      *(uint4*)((u16*)(p.ws + OFF_KEYS) + (size_t)r * 2048 + tid * 8) = pack8(f);
      continue;
    } r -= J_KEYS;
    if (r < J_MOD) {
      const int li = r / 96, n0 = (r % 96) * 64;
      float* sc = (float*)lds;
      float* red = sc + 9 * 1024;
      __syncthreads();
      for (int i = tid; i < 9 * 1024; i += 256) {
        int mv = i >> 10, k = i & 1023;
        float v = (mv < 8) ? p.in[I_C][mv * 1024 + k] : p.in[I_CCTX][k];
        sc[i] = v * sigmoidf_(v);
      }
      __syncthreads();
      const int lane = tid & 63, wave = tid >> 6;
      float acc[9];
#pragma unroll
      for (int m = 0; m < 9; ++m) acc[m] = 0.f;
      const float* w = p.in[I_MODW] + (size_t)li * 1024 * 6144 + n0 + lane;
#pragma unroll 16
      for (int k = wave * 256; k < wave * 256 + 256; ++k) {
        float wv = w[(size_t)k * 6144];
#pragma unroll
        for (int m = 0; m < 9; ++m) acc[m] += sc[m * 1024 + k] * wv;
      }
#pragma unroll
      for (int m = 0; m < 9; ++m) red[(wave * 9 + m) * 64 + lane] = acc[m];
      __syncthreads();
      for (int i = tid; i < 9 * 64; i += 256) {
        int m = i >> 6, l = i & 63;
        float s = red[(0 * 9 + m) * 64 + l] + red[(1 * 9 + m) * 64 + l] + red[(2 * 9 + m) * 64 + l] + red[(3 * 9 + m) * 64 + l];
        ((float*)(p.ws + OFF_MOD))[(size_t)(li * 9 + m) * 6144 + n0 + l] = s + p.in[I_MODB][li * 6144 + n0 + l];
      }
      continue;
    } r -= J_MOD;
    if (r < J_H2) {
      const int li = r / 1088; const int q4 = r % 1088;
      const int tl = tid >> 6, j = tid & 63;
      const int row = q4 * 4 + tl;
      const float tn = row < 4096 ? (float)row / 4096.f : (float)(row - 4096) / 256.f;
      float* h1s = (float*)lds;
      __syncthreads();
      const float* w1 = p.in[I_HYW1] + (size_t)li * 33 * 64;
      float a = tn * w1[j];
#pragma unroll 4
      for (int k = 1; k <= 16; ++k) {
        float rev = tn * (float)k;
        a += __builtin_amdgcn_cosf(rev) * w1[k * 64 + j] + __builtin_amdgcn_sinf(rev) * w1[(16 + k) * 64 + j];
      }
      a = fsin(p.in[I_HYF1][li * 64 + j] * (a + p.in[I_HYB1][li * 64 + j]));
      h1s[tl * 64 + j] = a;
      __syncthreads();
      const float* w2 = p.in[I_HYW2] + (size_t)li * 64 * 64;
      float b = 0.f;
#pragma unroll 8
      for (int i = 0; i < 64; ++i) b += h1s[tl * 64 + i] * w2[i * 64 + j];
      b = fsin(p.in[I_HYF2][li * 64 + j] * (b + p.in[I_HYB2][li * 64 + j]));
      ((float*)(p.ws + OFF_H2))[((size_t)li * 4352 + row) * 64 + j] = b;
      continue;
    } r -= J_H2;
    if (r < J_TW) {
      int k = r * 256 + tid;
      float rev = (float)k / 8192.f;
      float2 w; w.x = __builtin_amdgcn_cosf(rev); w.y = -__builtin_amdgcn_sinf(rev);
      ((float2*)(p.ws + OFF_TW))[k] = w;
      continue;
    } r -= J_TW;
    {
      int e = r * 256 + tid;
      int l = e >> 4, ai = e & 15, a = ai >> 3, i = ai & 7;
      float pos = a == 0 ? (float)(l >> 6) : (float)(l & 63);
      float inv = exp2f(-(float)i * (13.287712379549449f / 8.f));
      float ang = pos * inv;
      ((float*)(p.ws + OFF_ROPE))[e] = fcos(ang);
      ((float*)(p.ws + OFF_ROPE))[65536 + e] = fsin(ang);
    }
  }
}

DEV void norm_row_store(const float* xr, const float* gain, const float* sc, const float* sh, u16* dst, int lane) {
  float4 v[4]; float ss = 0.f;
#pragma unroll
  for (int j = 0; j < 4; ++j) { v[j] = *(const float4*)(xr + j * 256 + lane * 4); ss += v[j].x * v[j].x + v[j].y * v[j].y + v[j].z * v[j].z + v[j].w * v[j].w; }
  ss = wave_sum(ss);
  const float rstd = rsqrtf(ss * (1.f / 1024.f) + 1e-6f);
#pragma unroll
  for (int j = 0; j < 4; ++j) {
    const int n = j * 256 + lane * 4;
    float4 g = *(const float4*)(gain + n), s = *(const float4*)(sc + n), h = *(const float4*)(sh + n);
    uint2 o;
    o.x = pack2(v[j].x * rstd * g.x * (1.f + s.x) + h.x, v[j].y * rstd * g.y * (1.f + s.y) + h.y);
    o.y = pack2(v[j].z * rstd * g.z * (1.f + s.z) + h.z, v[j].w * rstd * g.w * (1.f + s.w) + h.w);
    *(uint2*)(dst + n) = o;
  }
}
DEV void norm_pass(const Params& p, int li, bool orig, const float* gain, int sc_chunk, int sh_chunk, int ntok) {
  const int tid_ = opaque_tid(); const int lane = tid_ & 63, wave = tid_ >> 6;
#pragma unroll 2
  for (int item = blockIdx.x; item < ntok / 4; item += gridDim.x) {
    const int tok = item * 4 + wave;
    const int mv = tok_mv(tok);
    norm_row_store(xsrc(p, tok, orig), gain, modp(p, li, mv, sc_chunk), modp(p, li, mv, sh_chunk), (u16*)(p.ws + OFF_XN) + (size_t)tok * D, lane);
  }
}

DEV float2 cmul(float2 a, float2 b) { return make_float2(a.x * b.x - a.y * b.y, a.x * b.y + a.y * b.x); }
DEV float2* stage_tw(const Params& p, unsigned char* lds) {
  float2* TWs = (float2*)(lds + 65536);
  const float2* TWg = (const float2*)(p.ws + OFF_TW);
  const int tid = opaque_tid();
  __syncthreads();
  for (int i = tid; i < 4096; i += 256) TWs[i] = TWg[i];
  __syncthreads();
  return TWs;
}
DEV float2 cadd(float2 a, float2 b) { return make_float2(a.x + b.x, a.y + b.y); }
DEV float2 csub(float2 a, float2 b) { return make_float2(a.x - b.x, a.y - b.y); }
DEV float2 cconj(float2 a) { return make_float2(a.x, -a.y); }
DEV void fft_fwd(float2* buf, int logn, const float2* TW) {
  const int tid = opaque_tid();
  const int sh = 13 - logn, nq = 1 << (logn - 2);
  for (int s = logn - 1; s >= 1; s -= 2) {
    const int h1 = 1 << s, h2 = h1 >> 1;
#pragma unroll 2
    for (int i = tid; i < nq; i += 256) {
      const int p = i & (h2 - 1);
      const int a = ((i >> (s - 1)) << (s + 1)) + p;
      const float2 w1a = TW[(p << (logn - 1 - s)) << sh], w1b = TW[((p + h2) << (logn - 1 - s)) << sh], w2 = TW[(p << (logn - s)) << sh];
      const float2 x0 = buf[a], x1 = buf[a + h2], x2 = buf[a + h1], x3 = buf[a + h1 + h2];
      const float2 y0 = cadd(x0, x2), y2 = cmul(csub(x0, x2), w1a);
      const float2 y1 = cadd(x1, x3), y3 = cmul(csub(x1, x3), w1b);
      buf[a] = cadd(y0, y1); buf[a + h2] = cmul(csub(y0, y1), w2);
      buf[a + h1] = cadd(y2, y3); buf[a + h1 + h2] = cmul(csub(y2, y3), w2);
    }
    __syncthreads();
  }
  {
    const int nh = 1 << (logn - 1);
#pragma unroll 2
    for (int i = tid; i < nh; i += 256) {
      const float2 x = buf[2 * i], y = buf[2 * i + 1];
      buf[2 * i] = cadd(x, y); buf[2 * i + 1] = csub(x, y);
    }
    __syncthreads();
  }
}
DEV void fft_inv(float2* buf, int logn, const float2* TW) {
  const int tid = opaque_tid();
  const int sh = 13 - logn, nq = 1 << (logn - 2);
  {
    const int nh = 1 << (logn - 1);
#pragma unroll 2
    for (int i = tid; i < nh; i += 256) {
      const float2 x = buf[2 * i], y = buf[2 * i + 1];
      buf[2 * i] = cadd(x, y); buf[2 * i + 1] = csub(x, y);
    }
    __syncthreads();
  }
  for (int s = 2; s <= logn - 1; s += 2) {
    const int h1 = 1 << s, h2 = h1 >> 1;
#pragma unroll 2
    for (int i = tid; i < nq; i += 256) {
      const int p = i & (h2 - 1);
      const int a = ((i >> (s - 1)) << (s + 1)) + p;
      const float2 w1a = cconj(TW[(p << (logn - 1 - s)) << sh]), w1b = cconj(TW[((p + h2) << (logn - 1 - s)) << sh]), w2 = cconj(TW[(p << (logn - s)) << sh]);
      const float2 z0 = buf[a], z1 = buf[a + h2], z2 = buf[a + h1], z3 = buf[a + h1 + h2];
      const float2 t1 = cmul(z1, w2), t3 = cmul(z3, w2);
      const float2 y0 = cadd(z0, t1), y1 = csub(z0, t1), y2 = cadd(z2, t3), y3 = csub(z2, t3);
      const float2 u2 = cmul(y2, w1a), u3 = cmul(y3, w1b);
      buf[a] = cadd(y0, u2); buf[a + h1] = csub(y0, u2);
      buf[a + h2] = cadd(y1, u3); buf[a + h1 + h2] = csub(y1, u3);
    }
    __syncthreads();
  }
}

DEV void mla_item(const Params& p, int li, int item, unsigned char* lds) {
  const int tid = opaque_tid(), lane = tid & 63, wave = tid >> 6;
  const int tok0 = item * 64 + wave * 16;
  __syncthreads();
  u16* Aq = (u16*)(lds + wave * 15360);
  u16* Akv = Aq + 16 * 264;
  float* KR = (float*)(Akv + 16 * 136);
  float* SSR = KR + 16 * 32;
  const u16* Pmh = (const u16*)(p.ws + OFF_PMH);
  const bool lat = tok0 < TLAT;
  const int b = lat ? (tok0 >> 12) : ((tok0 - TLAT) >> 8);
  const int kidx0 = lat ? (tok0 & 4095) : (4096 + ((tok0 - TLAT) & 255));
  {
    const int row = lane >> 2, sub = lane & 3;
    const u16* rp = Pmh + (size_t)(tok0 + row) * 1184;
    uint4 v[13];
#pragma unroll
    for (int i = 0; i < 13; ++i) v[i] = *(const uint4*)(rp + (sub + 4 * i) * 8);
    float ssq = 0.f, sskv = 0.f, ssr = 0.f;
    float f[8];
#pragma unroll
    for (int i = 0; i < 13; ++i) {
      unpack8(v[i], f);
      float s = 0.f;
#pragma unroll
      for (int j = 0; j < 8; ++j) s += f[j] * f[j];
      if (i < 8) ssq += s; else if (i < 12) sskv += s; else ssr += s;
    }
    ssq = sum4(ssq); sskv = sum4(sskv); ssr = sum4(ssr);
    const float rq = rsqrtf(ssq * (1.f / 256.f) + 1e-6f), rkv = rsqrtf(sskv * (1.f / 128.f) + 1e-6f);
    const float* qn = p.in[I_MQNORM] + li * 256;
    const float* kvn = p.in[I_MKVNORM] + li * 128;
#pragma unroll
    for (int i = 0; i < 13; ++i) {
      unpack8(v[i], f);
      if (i < 8) {
        const int col = (sub + 4 * i) * 8;
#pragma unroll
        for (int j = 0; j < 8; ++j) f[j] = f[j] * rq * qn[col + j];
        *(uint4*)(Aq + row * 264 + col) = pack8(f);
      } else if (i < 12) {
        const int col = (sub + 4 * i - 32) * 8;
#pragma unroll
        for (int j = 0; j < 8; ++j) f[j] = f[j] * rkv * kvn[col + j];
        *(uint4*)(Akv + row * 136 + col) = pack8(f);
      } else {
#pragma unroll
        for (int j = 0; j < 8; ++j) KR[row * 32 + sub * 8 + j] = f[j];
      }
    }
    if (sub == 0) SSR[row] = ssr;
  }
  __builtin_amdgcn_fence(__ATOMIC_RELEASE, "wavefront");
  __builtin_amdgcn_wave_barrier();
  __builtin_amdgcn_fence(__ATOMIC_ACQUIRE, "wavefront");
  const int c = lane & 15, quad = lane >> 4;
  const float* RC = (const float*)(p.ws + OFF_ROPE);
  const float* RS = RC + 65536;
  const float QSCALE = 0.10206207261596577f * 1.4426950408889634f;
  u16* QB = (u16*)(p.ws + OFF_QB);
  u16* KB = (u16*)(p.ws + OFF_KB);
  u16* VT = (u16*)(p.ws + OFF_VT);
  {
    const u16* W = (const u16*)(p.ws + OFF_WUQ) + (size_t)li * 576 * 256;
    const float* qg = p.in[I_MQGAIN] + li * 96;
#pragma unroll 1
    for (int h = 0; h < 6; ++h) {
      f32x4 acc[6];
#pragma unroll
      for (int j = 0; j < 6; ++j) acc[j] = (f32x4){0.f, 0.f, 0.f, 0.f};
#pragma unroll
      for (int ks = 0; ks < 8; ++ks) {
        const bf16x8 af = *(const bf16x8*)(Aq + c * 264 + ks * 32 + quad * 8);
#pragma unroll
        for (int j = 0; j < 6; ++j) {
          bf16x8 bb = *(const bf16x8*)(W + (size_t)(h * 96 + j * 16 + c) * 256 + ks * 32 + quad * 8);
          acc[j] = mfma16(af, bb, acc[j]);
        }
      }
#pragma unroll
      for (int r = 0; r < 4; ++r) {
        float s = 0.f;
#pragma unroll
        for (int j = 0; j < 6; ++j) s += acc[j][r] * acc[j][r];
        s = sum16(s);
        const float rs = rsqrtf(s * (1.f / 96.f) + 1e-6f) * QSCALE;
        const int rowi = quad * 4 + r;
        u16* dst = QB + ((size_t)(b * 6 + h) * KTOT + kidx0 + rowi) * 96;
#pragma unroll
        for (int j = 0; j < 4; ++j) dst[j * 16 + c] = f2bf(acc[j][r] * rs * qg[j * 16 + c]);
#pragma unroll
        for (int j = 4; j < 6; ++j) {
          float x = acc[j][r] * rs * qg[j * 16 + c];
          if (lat) {
            const float pr = __shfl_xor(x, 8);
            const int t = kidx0 + rowi;
            const float cs = RC[t * 16 + (j - 4) * 8 + (c & 7)], sn = RS[t * 16 + (j - 4) * 8 + (c & 7)];
            x = (c < 8) ? (x * cs - pr * sn) : (x * cs + pr * sn);
          }
          dst[j * 16 + c] = f2bf(x);
        }
      }
    }
  }
  {
    const u16* W = (const u16*)(p.ws + OFF_WUKV) + (size_t)li * 768 * 128;
    const float* kg = p.in[I_MKGAIN] + li * 96;
#pragma unroll 1
    for (int h = 0; h < 6; ++h) {
      f32x4 acc[8];
#pragma unroll
      for (int j = 0; j < 8; ++j) acc[j] = (f32x4){0.f, 0.f, 0.f, 0.f};
#pragma unroll
      for (int ks = 0; ks < 4; ++ks) {
        const bf16x8 af = *(const bf16x8*)(Akv + c * 136 + ks * 32 + quad * 8);
#pragma unroll
        for (int j = 0; j < 8; ++j) {
          bf16x8 bb = *(const bf16x8*)(W + (size_t)(h * 128 + j * 16 + c) * 128 + ks * 32 + quad * 8);
          acc[j] = mfma16(af, bb, acc[j]);
        }
      }
#pragma unroll
      for (int r = 0; r < 4; ++r) {
        const int rowi = quad * 4 + r;
        float s = 0.f;
#pragma unroll
        for (int j = 0; j < 4; ++j) s += acc[j][r] * acc[j][r];
        s = sum16(s);
        s += SSR[rowi];
        const float rk = rsqrtf(s * (1.f / 96.f) + 1e-6f);
        u16* dk = KB + ((size_t)(b * 6 + h) * KTOT + kidx0 + rowi) * 96;
#pragma unroll
        for (int j = 0; j < 4; ++j) dk[j * 16 + c] = f2bf(acc[j][r] * rk * kg[j * 16 + c]);
#pragma unroll
        for (int jj = 0; jj < 2; ++jj) {
          float x = KR[rowi * 32 + jj * 16 + c] * rk * kg[64 + jj * 16 + c];
          if (lat) {
            const float pr = KR[rowi * 32 + jj * 16 + (c ^ 8)] * rk * kg[64 + jj * 16 + (c ^ 8)];
            const int t = kidx0 + rowi;
            const float cs = RC[t * 16 + jj * 8 + (c & 7)], sn = RS[t * 16 + jj * 8 + (c & 7)];
            x = (c < 8) ? (x * cs - pr * sn) : (x * cs + pr * sn);
          }
          dk[64 + jj * 16 + c] = f2bf(x);
        }
#pragma unroll
        for (int j = 0; j < 4; ++j) VT[((size_t)(b * 6 + h) * 64 + j * 16 + c) * KTOT + kidx0 + rowi] = f2bf(acc[4 + j][r]);
      }
    }
  }
  __builtin_amdgcn_wave_barrier();
}

DEV void hy_item(const Params& p, int li, int part, int tt, unsigned char* lds) {
  const int tid = opaque_tid();
  u16* Z = (u16*)lds;
  int b, t0, L, tokbase; size_t obase;
  if (tt < 512) { b = tt >> 6; t0 = (tt & 63) * 64; L = 4096; tokbase = b * 4096; obase = (size_t)b * 256 * 4096; }
  else { int u = tt - 512; b = u >> 2; t0 = (u & 3) * 64; L = 256; tokbase = TLAT + b * 256; obase = (size_t)8 * 256 * 4096 + (size_t)b * 256 * 256; }
  const u16* Pmh = (const u16*)(p.ws + OFF_PMH);
  __syncthreads();
  for (int id = tid; id < 66 * 32; id += 256) {
    const int rr = id >> 5, ch = id & 31;
    const int t = t0 - 1 + rr;
    uint4 v = make_uint4(0, 0, 0, 0);
    if (t >= 0 && t < L) v = *(const uint4*)(Pmh + (size_t)(tokbase + t) * 1184 + 416 + part * 256 + ch * 8);
    *(uint4*)(Z + rr * 264 + ch * 8) = v;
  }
  __syncthreads();
  const int c = tid;
  const float* cw = p.in[I_HYCONV] + (size_t)li * 3 * 768 + part * 256 + c;
  const float w0 = cw[0], w1 = cw[768], w2 = cw[1536];
  u16* dst = (u16*)(p.ws + OFF_HYIN) + (size_t)part * TT * 256 + obase + (size_t)c * L + t0;
#pragma unroll
  for (int g = 0; g < 8; ++g) {
    float f[8];
#pragma unroll
    for (int j = 0; j < 8; ++j) {
      const int t = g * 8 + j;
      f[j] = w0 * bf2f(Z[t * 264 + c]) + w1 * bf2f(Z[(t + 1) * 264 + c]) + w2 * bf2f(Z[(t + 2) * 264 + c]);
    }
    *(uint4*)(dst + g * 8) = pack8(f);
  }
}

DEV void rwg_item(const Params& p, int li, int item, unsigned char* lds) {
  const int tid = opaque_tid(), lane = tid & 63, wave = tid >> 6;
  const int tok0 = item * 64 + wave * 16;
  __syncthreads();
  u16* Ag = (u16*)(lds + wave * 16384);
  u16* BV = Ag + 16 * 128;
  const u16* Prw = (const u16*)(p.ws + OFF_PRW);
  const float* cw = p.in[I_RWCONV] + (size_t)li * 3 * 1408;
#pragma unroll
  for (int i = 0; i < 4; ++i) {
    const int unit = lane + 64 * i, row = unit >> 4, c8 = unit & 15;
    const int tok = tok0 + row; bool hp, hn; tok_nb(tok, hp, hn);
    float f[8];
    conv8(Prw, 1408, tok, hp, hn, 1280 + c8 * 8, cw + 1280 + c8 * 8, 1408, f);
#pragma unroll
    for (int j = 0; j < 8; ++j) f[j] = sigmoidf_(f[j]);
    *(uint4*)(Ag + row * 128 + c8 * 8) = pack8(f);
  }
  const float* rk = p.in[I_RWRK] + li * 384;
  for (int it = 0; it < 12; ++it) {
    const int rh = it / 6, h = it % 6;
    const int row = rh * 8 + (lane >> 3), c8 = lane & 7;
    const int tok = tok0 + row; bool hp, hn; tok_nb(tok, hp, hn);
    const int col = h * 64 + c8 * 8;
    float r8[8], k8[8], v8[8];
    conv8(Prw, 1408, tok, hp, hn, col, cw + col, 1408, r8);
    conv8(Prw, 1408, tok, hp, hn, 384 + col, cw + 384 + col, 1408, k8);
    conv8(Prw, 1408, tok, hp, hn, 768 + col, cw + 768 + col, 1408, v8);
    float s = 0.f;
#pragma unroll
    for (int j = 0; j < 8; ++j) s += r8[j] * k8[j] * rk[col + j];
    s = sum8(s);
#pragma unroll
    for (int j = 0; j < 8; ++j) v8[j] *= s;
    *(uint4*)(BV + row * 384 + col) = pack8(v8);
  }
  __builtin_amdgcn_fence(__ATOMIC_RELEASE, "wavefront");
  __builtin_amdgcn_wave_barrier();
  __builtin_amdgcn_fence(__ATOMIC_ACQUIRE, "wavefront");
  const int c = lane & 15, quad = lane >> 4;
  bf16x8 af[4];
#pragma unroll
  for (int ks = 0; ks < 4; ++ks) af[ks] = *(const bf16x8*)(Ag + c * 128 + ks * 32 + quad * 8);
  const u16* W = (const u16*)(p.ws + OFF_GUT) + (size_t)li * 384 * 128;
  u16* G = (u16*)(p.ws + OFF_G);
  u16* BG = (u16*)(p.ws + OFF_BG);
  for (int h = 0; h < 6; ++h) {
    f32x4 acc[4];
#pragma unroll
    for (int j = 0; j < 4; ++j) acc[j] = (f32x4){0.f, 0.f, 0.f, 0.f};
#pragma unroll
    for (int ks = 0; ks < 4; ++ks)
#pragma unroll
      for (int j = 0; j < 4; ++j) {
        bf16x8 bb = *(const bf16x8*)(W + (size_t)(h * 64 + j * 16 + c) * 128 + ks * 32 + quad * 8);
        acc[j] = mfma16(af[ks], bb, acc[j]);
      }
#pragma unroll
    for (int j = 0; j < 4; ++j)
#pragma unroll
      for (int r = 0; r < 4; ++r) {
        const int rowi = quad * 4 + r, col = h * 64 + j * 16 + c;
        const float g = acc[j][r];
        G[(size_t)(tok0 + rowi) * 384 + col] = f2bf(g);
        BG[(size_t)(tok0 + rowi) * 384 + col] = f2bf(g * bf2f(BV[rowi * 384 + col]));
      }
  }
  __builtin_amdgcn_wave_barrier();
}

DEV void filt_item(const Params& p, int li, int sel, int o, int c, unsigned char* lds, const float2* TWs) {
  const int tid = opaque_tid();
  const int L = sel ? 256 : 4096, logn = sel ? 9 : 13, N2 = 2 * L;
  float2* buf = (float2*)lds;
  const int col0 = o * 512 + c, col1 = col0 + 256;
  __syncthreads();
  const float* w3a = p.in[I_HYW3] + (size_t)li * 64 * 1024 + col0;
  const float* w3b = w3a + 256;
  const float b30 = p.in[I_HYB3][li * 1024 + col0], b31 = p.in[I_HYB3][li * 1024 + col1];
  const float rate = 3.0701134573253946f + (15.350567286626972f - 3.0701134573253946f) * (float)c * (1.f / 255.f);
  const float* H2 = (const float*)(p.ws + OFF_H2) + ((size_t)li * 4352 + (sel ? 4096 : 0)) * 64;
  float ss = 0.f;
#pragma unroll 1
  for (int dd = 0; dd < 2; ++dd) {
    const float* w3 = dd ? w3b : w3a;
    const float b3v = dd ? b31 : b30;
    for (int t = tid; t < L; t += 256) {
      const float4* hr = (const float4*)(H2 + (size_t)t * 64);
      float d0 = b3v;
#pragma unroll
      for (int i = 0; i < 16; ++i) {
        float4 h = hr[i];
        d0 += h.x * w3[(i * 4) * 1024] + h.y * w3[(i * 4 + 1) * 1024] + h.z * w3[(i * 4 + 2) * 1024] + h.w * w3[(i * 4 + 3) * 1024];
      }
      const float v0 = d0 * __expf(-((float)t / (float)L) * rate);
      if (dd == 0) { buf[t] = make_float2(v0, 0.f); ss += v0 * v0; }
      else if (t >= 1) { buf[N2 - t] = make_float2(v0, 0.f); ss += v0 * v0; }
    }
  }
  ss = wave_sum(ss);
  float tot = 0.f;
  if ((tid & 63) == 0 && tid < 128) ((float*)&buf[L])[tid >> 6] = ss;
  __syncthreads();
  tot += buf[L].x + buf[L].y;
  __syncthreads();
  if ((tid & 63) == 0 && tid >= 128) ((float*)&buf[L])[(tid >> 6) - 2] = ss;
  __syncthreads();
  tot += buf[L].x + buf[L].y;
  __syncthreads();
  if (tid == 0) buf[L] = make_float2(0.f, 0.f);
  __syncthreads();
  const float scale = rsqrtf(tot) / (float)N2;
  fft_fwd(buf, logn, TWs);
  float2* HF = (float2*)(p.ws + OFF_HF) + (sel ? (size_t)2 * 256 * 8192 : 0) + (size_t)(o * 256 + c) * N2;
  for (int i = tid; i < N2; i += 256) { float2 v = buf[i]; HF[i] = make_float2(v.x * scale, v.y * scale); }
}

DEV void phaseA(const Params& p, int li, unsigned char* lds) {
  const u16* XN = (const u16*)(p.ws + OFF_XN);
  const u16* Wt = (const u16*)(p.ws + OFF_WIN) + (size_t)li * 2688 * 1024;
  u16* Prw = (u16*)(p.ws + OFF_PRW);
  u16* Pmh = (u16*)(p.ws + OFF_PMH);
  const int n_filt = (li == 0) ? 1024 : 512;
  const float2* TWs = stage_tw(p, lds);
  const int vbid = ((gridDim.x & 7) == 0) ? (int)((blockIdx.x & 7) * (gridDim.x >> 3) + (blockIdx.x >> 3)) : (int)blockIdx.x;
  for (int item0 = vbid; item0 < 136 * 21 + n_filt; item0 += gridDim.x) {
    if (item0 < n_filt) { const int sel = item0 >> 9, r = item0 & 511; filt_item(p, li, sel, r >> 8, r & 255, lds, TWs); continue; }
    const int item = item0 - n_filt;
    const int m0 = (item / 21) * 256, n0 = (item % 21) * 128;
    gemm_tile<256, 128, 2, 2>(lds, 1024,
      [&](int row, int k) { return *(const uint4*)(XN + (size_t)(m0 + row) * 1024 + k); },
      [&](int row, int k) { return *(const uint4*)(Wt + (size_t)(n0 + row) * 1024 + k); },
      [&](int mrow, int ncol, f32x4 a) {
        const int n = n0 + ncol;
        if (n < 2592) {
#pragma unroll
          for (int r = 0; r < 4; ++r) {
            const int tok = m0 + mrow + r;
            if (n < 1408) Prw[(size_t)tok * 1408 + n] = f2bf(a[r]);
            else Pmh[(size_t)tok * 1184 + (n - 1408)] = f2bf(a[r]);
          }
        }
      });
  }
}


DEV void phaseB(const Params& p, int li, unsigned char* lds) {
  const bool need_ctx = (li == 0);
  const int n_mla = 544;
  const int n_hytt = need_ctx ? 544 : 512, n_hy = n_hytt * 3;
  const int n_rwg = need_ctx ? 544 : 512;
  const int total = n_mla + n_hy + n_rwg;
  for (int item = blockIdx.x; item < total; item += gridDim.x) {
    int r = item;
    if (r < n_mla) { mla_item(p, li, r, lds); continue; } r -= n_mla;
    if (r < n_hy) { hy_item(p, li, r / n_hytt, r % n_hytt, lds); continue; } r -= n_hy;
    rwg_item(p, li, r, lds);
  }
}

DEV void scan_item(const Params& p, int li, int item, unsigned char* lds) {
  const int tid = opaque_tid(), lane = tid & 63, wave = tid >> 6;
  const int dir = item & 1, bh = item >> 1, b = bh / 6, h = bh % 6;
  float* STEP = (float*)lds;
  u16* DL = (u16*)(lds + 49152);
  u16* AL = DL + 32 * 72;
  u16* YS = (u16*)(lds + 49152 + 2 * 32 * 72 * 2);
  const u16* Prw = (const u16*)(p.ws + OFF_PRW);
  const float* cw = p.in[I_RWCONV] + (size_t)li * 3 * 1408;
  const float* kkw = p.in[I_RWKK] + li * 384 + h * 64;
  const float* kaw = p.in[I_RWKA] + li * 384 + h * 64;
  const float* d0 = p.in[I_RWD0] + (size_t)(li * 2 + dir) * 384 + h * 64;
  const float* a0 = p.in[I_RWA0] + (size_t)(li * 2 + dir) * 384 + h * 64;
  const u16* DUT = (const u16*)(p.ws + OFF_DUT) + ((size_t)(li * 2 + dir) * 384 + h * 64) * 64;
  const u16* AUT = (const u16*)(p.ws + OFF_AUT) + ((size_t)(li * 2 + dir) * 384 + h * 64) * 64;
  u16* Yd = (u16*)(p.ws + (dir ? OFF_Y1 : OFF_Y0));
  const int vrow = tid >> 2, q = tid & 3;
  f32x2 S[8];
#pragma unroll
  for (int i = 0; i < 8; ++i) S[i] = (f32x2){0.f, 0.f};
  const int c = lane & 15, quad = lane >> 4;
  __syncthreads();
  for (int ch = 0; ch < 136; ++ch) {
    int tokbase, t0, L;
    if (ch < 8) { L = 256; tokbase = TLAT + b * 256; t0 = (dir ? (7 - ch) : ch) * 32; }
    else { L = 4096; tokbase = b * 4096; const int cc = ch - 8; t0 = (dir ? (127 - cc) : cc) * 32; }
#pragma unroll
    for (int i = 0; i < 5; ++i) {
      const int id = tid + 256 * i;
      const int c8 = id & 7, part = (id >> 3) % 5, tl = id / 40;
      const int t = t0 + tl, tok = tokbase + t;
      const int col = (part < 3) ? (part * 384 + h * 64 + c8 * 8) : (1152 + (part - 3) * 64 + c8 * 8);
      float f[8];
      conv8(Prw, 1408, tok, t > 0, t < L - 1, col, cw + col, 1408, f);
      float ssk = 0.f;
      float kr[8];
#pragma unroll
      for (int j = 0; j < 8; ++j) { kr[j] = f[j] * kkw[c8 * 8 + j]; ssk += kr[j] * kr[j]; }
      ssk = sum8(ssk);
      float* sp = STEP + tl * 384;
      if (part == 0) { *(float4*)(sp + 256 + c8 * 8) = make_float4(f[0], f[1], f[2], f[3]); *(float4*)(sp + 256 + c8 * 8 + 4) = make_float4(f[4], f[5], f[6], f[7]); }
      else if (part == 1) {
        *(float4*)(sp + 192 + c8 * 8) = make_float4(f[0], f[1], f[2], f[3]); *(float4*)(sp + 192 + c8 * 8 + 4) = make_float4(f[4], f[5], f[6], f[7]);
        const float rs = rsqrtf(ssk + 1e-12f);
        *(float4*)(sp + c8 * 8) = make_float4(kr[0] * rs, kr[1] * rs, kr[2] * rs, kr[3] * rs);
        *(float4*)(sp + c8 * 8 + 4) = make_float4(kr[4] * rs, kr[5] * rs, kr[6] * rs, kr[7] * rs);
      }
      else if (part == 2) { *(float4*)(sp + 320 + c8 * 8) = make_float4(f[0], f[1], f[2], f[3]); *(float4*)(sp + 320 + c8 * 8 + 4) = make_float4(f[4], f[5], f[6], f[7]); }
      else if (part == 3) {
#pragma unroll
        for (int j = 0; j < 8; ++j) f[j] = tanhf(f[j]);
        *(uint4*)(DL + tl * 72 + c8 * 8) = pack8(f);
      }
      else { *(uint4*)(AL + tl * 72 + c8 * 8) = pack8(f); }
    }
    __syncthreads();
    {
      const int mt = wave >> 1;
      bf16x8 ad[2], aa[2];
#pragma unroll
      for (int ks = 0; ks < 2; ++ks) {
        ad[ks] = *(const bf16x8*)(DL + (mt * 16 + c) * 72 + ks * 32 + quad * 8);
        aa[ks] = *(const bf16x8*)(AL + (mt * 16 + c) * 72 + ks * 32 + quad * 8);
      }
#pragma unroll
      for (int jn = 0; jn < 2; ++jn) {
        const int nt = (wave & 1) * 2 + jn;
        f32x4 accd = (f32x4){0.f, 0.f, 0.f, 0.f}, acca = accd;
#pragma unroll
        for (int ks = 0; ks < 2; ++ks) {
          bf16x8 bd = *(const bf16x8*)(DUT + (size_t)(nt * 16 + c) * 64 + ks * 32 + quad * 8);
          bf16x8 ba = *(const bf16x8*)(AUT + (size_t)(nt * 16 + c) * 64 + ks * 32 + quad * 8);
          accd = mfma16(ad[ks], bd, accd);
          acca = mfma16(aa[ks], ba, acca);
        }
        const int col = nt * 16 + c;
        const float d0c = d0[col], a0c = a0[col], kac = kaw[col];
#pragma unroll
        for (int r = 0; r < 4; ++r) {
          const int tl = mt * 16 + quad * 4 + r;
          float* sp = STEP + tl * 384;
          const float w = __expf(-0.6065306597f * sigmoidf_(d0c + accd[r]));
          const float a = sigmoidf_(a0c + acca[r]);
          const float kraw = sp[192 + col], kk = sp[col];
          sp[64 + col] = w;
          sp[128 + col] = a * kk;
          sp[192 + col] = kraw * (1.f + (a - 1.f) * kac);
        }
      }
    }
    __syncthreads();
#define SCAN_LOAD(TL, KK, W, AK, KR, RR, VV) { \
      const float* sp_ = STEP + (TL) * 384 + q * 16; \
      _Pragma("unroll") for (int i = 0; i < 4; ++i) { f32x4 t_; \
        t_ = *(const f32x4*)(sp_ + i * 4);        KK[2 * i] = t_.xy; KK[2 * i + 1] = t_.zw; \
        t_ = *(const f32x4*)(sp_ + 64 + i * 4);   W[2 * i] = t_.xy;  W[2 * i + 1] = t_.zw; \
        t_ = *(const f32x4*)(sp_ + 128 + i * 4);  AK[2 * i] = t_.xy; AK[2 * i + 1] = t_.zw; \
        t_ = *(const f32x4*)(sp_ + 192 + i * 4);  KR[2 * i] = t_.xy; KR[2 * i + 1] = t_.zw; \
        t_ = *(const f32x4*)(sp_ + 256 + i * 4);  RR[2 * i] = t_.xy; RR[2 * i + 1] = t_.zw; } \
      VV = STEP[(TL) * 384 + 320 + vrow]; }
#define SCAN_STEP(TL, KK, W, AK, KR, RR, VV) { \
      f32x2 pa = S[0] * KK[0], pb = S[1] * KK[1]; \
      _Pragma("unroll") for (int i = 2; i < 8; i += 2) { pa += S[i] * KK[i]; pb += S[i + 1] * KK[i + 1]; } \
      pa += pb; \
      float pd = sum4(pa.x + pa.y); \
      const f32x2 npd = (f32x2){-pd, -pd}, vv2 = (f32x2){VV, VV}; \
      f32x2 ya = (f32x2){0.f, 0.f}, yb = ya; \
      _Pragma("unroll") for (int i = 0; i < 8; i += 2) { \
        S[i] = S[i] * W[i] + (vv2 * KR[i] + npd * AK[i]); \
        S[i + 1] = S[i + 1] * W[i + 1] + (vv2 * KR[i + 1] + npd * AK[i + 1]); \
        ya += S[i] * RR[i]; yb += S[i + 1] * RR[i + 1]; } \
      ya += yb; \
      const float y = sum4(ya.x + ya.y); \
      if (q == 0) YS[(TL) * 64 + vrow] = f2bf(y); }
    for (int st = 0; st < 32; st += 2) {
      const int tl0 = dir ? (31 - st) : st, tl1 = dir ? (30 - st) : (st + 1);
      f32x2 kk0[8], w0[8], ak0[8], kr0[8], rr0[8], kk1[8], w1[8], ak1[8], kr1[8], rr1[8];
      float vv0, vv1;
      SCAN_LOAD(tl0, kk0, w0, ak0, kr0, rr0, vv0)
      SCAN_LOAD(tl1, kk1, w1, ak1, kr1, rr1, vv1)
      SCAN_STEP(tl0, kk0, w0, ak0, kr0, rr0, vv0)
      SCAN_STEP(tl1, kk1, w1, ak1, kr1, rr1, vv1)
    }
    __syncthreads();
    {
      const int tl = tid >> 3, c8 = tid & 7;
      *(uint4*)(Yd + (size_t)(tokbase + t0 + tl) * 384 + h * 64 + c8 * 8) = *(const uint4*)(YS + tl * 64 + c8 * 8);
    }
  }
}

DEV void attn_item(const Params& p, int b, int h, int q0, int kt0, int kt1, int tok_q0, unsigned char* lds) {
  const int tid = opaque_tid(), lane = tid & 63, wave = tid >> 6;
  const int c = lane & 15, quad = lane >> 4;
  u16* Ks = (u16*)lds;
  u16* Vs = Ks + 64 * 104;
  const size_t bh = (size_t)(b * 6 + h);
  const u16* QB = (const u16*)(p.ws + OFF_QB) + bh * KTOT * 96;
  const u16* KB = (const u16*)(p.ws + OFF_KB) + bh * KTOT * 96;
  const u16* VT = (const u16*)(p.ws + OFF_VT) + bh * 64 * KTOT;
  bf16x8 qf[4][3];
#pragma unroll
  for (int n = 0; n < 4; ++n)
#pragma unroll
    for (int ks = 0; ks < 3; ++ks) qf[n][ks] = *(const bf16x8*)(QB + (size_t)(q0 + wave * 64 + n * 16 + c) * 96 + ks * 32 + quad * 8);
  f32x4 ot[4][4];
#pragma unroll
  for (int d = 0; d < 4; ++d)
#pragma unroll
    for (int n = 0; n < 4; ++n) ot[d][n] = (f32x4){0.f, 0.f, 0.f, 0.f};
  float mrun[4] = {-1e30f, -1e30f, -1e30f, -1e30f}, lsum[4] = {0.f, 0.f, 0.f, 0.f};
  uint4 rk0, rk1, rk2, rv0, rv1;
#define ATT_KLD(KT, I) (*(const uint4*)(KB + (size_t)((KT) * 64 + (tid + 256 * (I)) / 12) * 96 + ((tid + 256 * (I)) % 12) * 8))
#define ATT_VLD(KT, I) (*(const uint4*)(VT + (size_t)((tid + 256 * (I)) >> 3) * KTOT + (KT) * 64 + ((tid + 256 * (I)) & 7) * 8))
#define ATT_GLOAD(KT) { rk0 = ATT_KLD(KT, 0); rk1 = ATT_KLD(KT, 1); rk2 = ATT_KLD(KT, 2); rv0 = ATT_VLD(KT, 0); rv1 = ATT_VLD(KT, 1); }
  ATT_GLOAD(kt0);
  for (int kt = kt0; kt < kt1; ++kt) {
    __syncthreads();
    { const int id = tid; *(uint4*)(Ks + (id / 12) * 104 + (id % 12) * 8) = rk0; }
    { const int id = tid + 256; *(uint4*)(Ks + (id / 12) * 104 + (id % 12) * 8) = rk1; }
    { const int id = tid + 512; *(uint4*)(Ks + (id / 12) * 104 + (id % 12) * 8) = rk2; }
    { const int id = tid; uint2* d = (uint2*)(Vs + (id >> 3) * 68 + (id & 7) * 8); d[0] = make_uint2(rv0.x, rv0.y); d[1] = make_uint2(rv0.z, rv0.w); }
    { const int id = tid + 256; uint2* d = (uint2*)(Vs + (id >> 3) * 68 + (id & 7) * 8); d[0] = make_uint2(rv1.x, rv1.y); d[1] = make_uint2(rv1.z, rv1.w); }
    __syncthreads();
    if (kt + 1 < kt1) ATT_GLOAD(kt + 1);
    f32x4 st[4][4];
#pragma unroll
    for (int i = 0; i < 4; ++i)
#pragma unroll
      for (int n = 0; n < 4; ++n) st[i][n] = (f32x4){0.f, 0.f, 0.f, 0.f};
#pragma unroll
    for (int ks = 0; ks < 3; ++ks)
#pragma unroll
      for (int i = 0; i < 4; ++i) {
        const bf16x8 ak = *(const bf16x8*)(Ks + (i * 16 + c) * 104 + ks * 32 + quad * 8);
#pragma unroll
        for (int n = 0; n < 4; ++n) st[i][n] = mfma16(ak, qf[n][ks], st[i][n]);
      }
    bf16x8 pb[4][2];
#pragma unroll
    for (int n = 0; n < 4; ++n) {
      float mx = st[0][n][0];
#pragma unroll
      for (int i = 0; i < 4; ++i)
#pragma unroll
        for (int r = 0; r < 4; ++r) mx = fmaxf(mx, st[i][n][r]);
      mx = fmaxf(mx, __shfl_xor(mx, 16)); mx = fmaxf(mx, __shfl_xor(mx, 32));
      const float mnew = fmaxf(mrun[n], mx);
      const float alpha = __builtin_amdgcn_exp2f(mrun[n] - mnew);
      mrun[n] = mnew;
      float ls = 0.f;
      float pv[16];
#pragma unroll
      for (int i = 0; i < 4; ++i)
#pragma unroll
        for (int r = 0; r < 4; ++r) { const float e = __builtin_amdgcn_exp2f(st[i][n][r] - mnew); pv[i * 4 + r] = e; ls += e; }
      lsum[n] = lsum[n] * alpha + ls;
      if (__builtin_amdgcn_ballot_w64(alpha != 1.0f) != 0ull) {
#pragma unroll
        for (int d = 0; d < 4; ++d) ot[d][n] *= alpha;
      }
#pragma unroll
      for (int kk = 0; kk < 2; ++kk) pb[n][kk] = as_bf8(pack8(pv + kk * 8));
    }
#pragma unroll
    for (int kk = 0; kk < 2; ++kk)
#pragma unroll
      for (int d = 0; d < 4; ++d) {
        const uint2 lo = *(const uint2*)(Vs + (d * 16 + c) * 68 + kk * 32 + quad * 4);
        const uint2 hi = *(const uint2*)(Vs + (d * 16 + c) * 68 + kk * 32 + 16 + quad * 4);
        const bf16x8 av = as_bf8(make_uint4(lo.x, lo.y, hi.x, hi.y));
#pragma unroll
        for (int n = 0; n < 4; ++n) ot[d][n] = mfma16(av, pb[n][kk], ot[d][n]);
      }
  }
  u16* ATT = (u16*)(p.ws + OFF_ATT);
#pragma unroll
  for (int n = 0; n < 4; ++n) {
    float l = lsum[n];
    l += __shfl_xor(l, 16); l += __shfl_xor(l, 32);
    const float inv = 1.f / l;
    const int tok = tok_q0 + wave * 64 + n * 16 + c;
#pragma unroll
    for (int d = 0; d < 4; ++d) {
      uint2 o;
      o.x = pack2(ot[d][n][0] * inv, ot[d][n][1] * inv);
      o.y = pack2(ot[d][n][2] * inv, ot[d][n][3] * inv);
      *(uint2*)(ATT + (size_t)tok * 384 + h * 64 + d * 16 + quad * 4) = o;
    }
  }
}

template <int NJ>
DEV void hyfft_item(const Params& p, int li, int c, int bp, unsigned char* lds, const float2* TW) {
  constexpr int L = NJ * 256, N2 = 2 * L, logn = (NJ == 16) ? 13 : 9;
  const int tid = opaque_tid();
  float2* buf = (float2*)lds;
  const size_t seqoff = (NJ == 16) ? 0 : (size_t)8 * 256 * 4096;
  const size_t o0 = seqoff + ((size_t)(2 * bp) * 256 + c) * L, o1 = seqoff + ((size_t)(2 * bp + 1) * 256 + c) * L;
  const u16* HG0 = (const u16*)(p.ws + OFF_HYIN);
  const u16* HG1 = HG0 + (size_t)TT * 256;
  const u16* HU = HG1 + (size_t)TT * 256;
  u16* HO = (u16*)(p.ws + OFF_HYO);
  const float2* HF = (const float2*)(p.ws + OFF_HF) + ((NJ == 16) ? 0 : (size_t)2 * 256 * 8192);
  float2 yr[NJ];
  __syncthreads();
#pragma unroll
  for (int j = 0; j < NJ; ++j) {
    const int t = tid + 256 * j;
    yr[j] = make_float2(bf2f(HU[o0 + t]), bf2f(HU[o1 + t]));
    buf[t] = yr[j];
    buf[L + t] = make_float2(0.f, 0.f);
  }
  __syncthreads();
#pragma unroll 1
  for (int o = 0; o < 2; ++o) {
    fft_fwd(buf, logn, TW);
    const float2* hf = HF + (size_t)(o * 256 + c) * N2;
    for (int i = tid; i < N2; i += 256) buf[i] = cmul(buf[i], hf[i]);
    __syncthreads();
    fft_inv(buf, logn, TW);
    const float bias = p.in[I_HYBIAS][(li * 2 + o) * 256 + c];
    const u16* HG = o ? HG1 : HG0;
#pragma unroll
    for (int j = 0; j < NJ; ++j) {
      const int t = tid + 256 * j;
      const float2 v = buf[t];
      yr[j].x = bf2f(HG[o0 + t]) * (v.x + yr[j].x * bias);
      yr[j].y = bf2f(HG[o1 + t]) * (v.y + yr[j].y * bias);
    }
    __syncthreads();
    if (o == 0) {
#pragma unroll
      for (int j = 0; j < NJ; ++j) { const int t = tid + 256 * j; buf[t] = yr[j]; buf[L + t] = make_float2(0.f, 0.f); }
      __syncthreads();
    } else {
#pragma unroll
      for (int j = 0; j < NJ; ++j) { const int t = tid + 256 * j; HO[o0 + t] = f2bf(yr[j].x); HO[o1 + t] = f2bf(yr[j].y); }
    }
  }
}

DEV void phaseC(const Params& p, int li, unsigned char* lds, int cidx = -1, int only = 0) {
  const bool need_ctx = (li == 0);
  const int n_scan = (only == 0 || only == 1) ? 96 : 0, n_attn = (only == 0 || only == 2) ? 768 : 0, n_fft = (only == 0 || only == 3) ? 1024 : 0, n_attc = (need_ctx && only == 0) ? 48 : 0, n_fftc = (need_ctx && only == 0) ? 1024 : 0;
  const int total = n_scan + n_attn + n_fft + n_attc + n_fftc;
  const float2* TWs = stage_tw(p, lds);
  unsigned* ctr = (unsigned*)(p.ws + OFF_CTR) + (cidx < 0 ? li : cidx);
  int* sitem = (int*)(lds + LDS_BYTES - 16);
  for (;;) {
    __syncthreads();
    if (threadIdx.x == 0) *sitem = (int)atomicAdd(ctr, 1u);
    __syncthreads();
    int r = *sitem;
    if (r >= total) break;
    if (r < n_scan) { scan_item(p, li, r, lds); continue; } r -= n_scan;
    if (r < n_attn) { const int bh = r >> 4, qt = r & 15; const int b = bh / 6, h = bh % 6; attn_item(p, b, h, qt * 256, 0, 68, b * 4096 + qt * 256, lds); continue; } r -= n_attn;
    if (r < n_fft) { hyfft_item<16>(p, li, r >> 2, r & 3, lds, TWs); continue; } r -= n_fft;
    if (r < n_attc) { const int bh = r; const int b = bh / 6, h = bh % 6; attn_item(p, b, h, 4096, 64, 68, TLAT + b * 256, lds); continue; } r -= n_attc;
    hyfft_item<1>(p, li, r >> 2, r & 3, lds, TWs);
  }
}

constexpr size_t OFF_MIX = OFF_QB;
DEV void phaseD0(const Params& p, int li) {
  const int tid = opaque_tid();
  const int ntok = (li == 0) ? TT : TLAT;
  const u16* Y0 = (const u16*)(p.ws + OFF_Y0);
  const u16* Y1 = (const u16*)(p.ws + OFF_Y1);
  const u16* G = (const u16*)(p.ws + OFF_G);
  const u16* BG = (const u16*)(p.ws + OFF_BG);
  const u16* ATT = (const u16*)(p.ws + OFF_ATT);
  const u16* HO = (const u16*)(p.ws + OFF_HYO);
  u16* MIX = (u16*)(p.ws + OFF_MIX);
  const float* gng = p.in[I_RWGNG] + li * 384;
  const float* gnb = p.in[I_RWGNB] + li * 384;
  for (int item = blockIdx.x; item < ntok / 32; item += gridDim.x) {
    const int tok = item * 32 + (tid >> 3), c8 = tid & 7;
#pragma unroll 2
    for (int kg = 0; kg < 16; ++kg) {
      const int k = kg * 64 + c8 * 8;
      uint4 o;
      if (kg < 6) {
        float a[8], bb[8], y[8];
        unpack8(*(const uint4*)(Y0 + (size_t)tok * 384 + k), a);
        unpack8(*(const uint4*)(Y1 + (size_t)tok * 384 + k), bb);
        float sm = 0.f;
#pragma unroll
        for (int j = 0; j < 8; ++j) { y[j] = a[j] + bb[j]; sm += y[j]; }
        sm = sum8(sm);
        const float mu = sm * (1.f / 64.f);
        float v = 0.f;
#pragma unroll
        for (int j = 0; j < 8; ++j) { y[j] -= mu; v += y[j] * y[j]; }
        v = sum8(v);
        const float rstd = rsqrtf(v * (1.f / 64.f) + 64e-5f);
        float g[8], bg[8];
        unpack8(*(const uint4*)(G + (size_t)tok * 384 + k), g);
        unpack8(*(const uint4*)(BG + (size_t)tok * 384 + k), bg);
#pragma unroll
        for (int j = 0; j < 8; ++j) y[j] = (y[j] * rstd * gng[k + j] + gnb[k + j]) * g[j] + bg[j];
        o = pack8(y);
      } else if (kg < 12) {
        o = *(const uint4*)(ATT + (size_t)tok * 384 + (k - 384));
      } else {
        const int ch = k - 768;
        const u16* src; int L;
        if (tok < TLAT) { L = 4096; src = HO + ((size_t)(tok >> 12) * 256 + ch) * 4096 + (tok & 4095); }
        else { L = 256; const int u = tok - TLAT; src = HO + (size_t)8 * 256 * 4096 + ((size_t)(u >> 8) * 256 + ch) * 256 + (u & 255); }
        o.x = (unsigned)src[0] | ((unsigned)src[(size_t)L] << 16);
        o.y = (unsigned)src[(size_t)2 * L] | ((unsigned)src[(size_t)3 * L] << 16);
        o.z = (unsigned)src[(size_t)4 * L] | ((unsigned)src[(size_t)5 * L] << 16);
        o.w = (unsigned)src[(size_t)6 * L] | ((unsigned)src[(size_t)7 * L] << 16);
      }
      *(uint4*)(MIX + (size_t)tok * 1024 + k) = o;
    }
  }
}
DEV void phaseD1(const Params& p, int li, unsigned char* lds) {
  const bool orig = (li == 0);
  const int nmt = (li == 0) ? 272 : 256;
  const u16* Wt = (const u16*)(p.ws + OFF_WOUT) + (size_t)li * 1024 * 1024;
  const u16* MIX = (const u16*)(p.ws + OFF_MIX);
  for (int item = blockIdx.x; item < nmt * 8; item += gridDim.x) {
    const int m0 = (item >> 3) * 128, n0 = (item & 7) * 128;
    gemm_tile<128, 128, 2, 2>(lds, 1024,
      [&](int row, int k) { return *(const uint4*)(MIX + (size_t)(m0 + row) * 1024 + k); },
      [&](int row, int k) { return *(const uint4*)(Wt + (size_t)(n0 + row) * 1024 + k); },
      [&](int mrow, int ncol, f32x4 a) {
        const int n = n0 + ncol;
#pragma unroll
        for (int r = 0; r < 4; ++r) {
          const int tok = m0 + mrow + r;
          const float gm = modp(p, li, tok_mv(tok), 2)[n];
          xdst(p, tok)[n] = xsrc(p, tok, orig)[n] + gm * a[r];
        }
      });
  }
}

constexpr size_t OFF_PUB = OFF_PRW;
typedef float f32x2v __attribute__((ext_vector_type(2)));
DEV unsigned pack_fp8x4(float a, float b, float c, float d) {
  int p = __builtin_amdgcn_cvt_pk_fp8_f32(a, b, 0, false);
  p = __builtin_amdgcn_cvt_pk_fp8_f32(c, d, p, true);
  return (unsigned)p;
}
DEV void unpack_fp8x4(unsigned v, float* f) {
  const f32x2v lo = __builtin_amdgcn_cvt_pk_f32_fp8((int)v, false), hi = __builtin_amdgcn_cvt_pk_f32_fp8((int)v, true);
  f[0] = lo.x; f[1] = lo.y; f[2] = hi.x; f[3] = hi.y;
}
constexpr float PEER_USCALE = 64.f, PEER_VSCALE = 4.f;
DEV void cvt_peer(const Params& p, int li) {
  const int tid = opaque_tid();
  const float* PU = p.in[I_PU] + (size_t)li * 16384 * 1024;
  const float* PV = p.in[I_PV] + (size_t)li * 16384 * 1024;
  unsigned char* dst = p.ws + OFF_PUB;
#pragma unroll 4
  for (int item = blockIdx.x; item < 16384; item += gridDim.x) {
    const bool isu = item < 8192;
    const float* src = isu ? PU + (size_t)item * 2048 : PV + (size_t)(item - 8192) * 2048;
    const float sc = isu ? PEER_USCALE : PEER_VSCALE;
    const float4 a = *(const float4*)(src + tid * 8), b = *(const float4*)(src + tid * 8 + 4);
    uint2 o;
    o.x = pack_fp8x4(a.x * sc, a.y * sc, a.z * sc, a.w * sc);
    o.y = pack_fp8x4(b.x * sc, b.y * sc, b.z * sc, b.w * sc);
    *(uint2*)(dst + (size_t)item * 2048 + tid * 8) = o;
  }
}

DEV unsigned fkey(float x) { const unsigned u = __float_as_uint(x); return (u & 0x80000000u) ? ~u : (u | 0x80000000u); }
DEV float funkey(unsigned k) { return __uint_as_float((k & 0x80000000u) ? (k ^ 0x80000000u) : ~k); }
DEV unsigned umax16(unsigned m) {
  m = max(m, (unsigned)dppi<0x128>((int)m)); m = max(m, (unsigned)dppi<0x124>((int)m));
  m = max(m, (unsigned)dppi<0x122>((int)m)); m = max(m, (unsigned)dppi<0x121>((int)m));
  return m;
}
DEV bool better(float v, int i, float ov, int oi) { return v > ov || (v == ov && i < oi); }
#define ARGMAX16_STEP(V, I, CTRL) { const float ov_ = dppf<CTRL>(V); const int oi_ = dppi<CTRL>(I); if (better(ov_, oi_, V, I)) { V = ov_; I = oi_; } }
#define ARGMAX16(V, I) ARGMAX16_STEP(V, I, 0x128) ARGMAX16_STEP(V, I, 0x124) ARGMAX16_STEP(V, I, 0x122) ARGMAX16_STEP(V, I, 0x121)
DEV void phaseD3(const Params& p, int li, unsigned char* lds) {
  const int nmt = (li == 0) ? 272 : 256;
  const u16* XN = (const u16*)(p.ws + OFF_XN);
  const int tid = opaque_tid(), lane = tid & 63, wave = tid >> 6;
  const int c = lane & 15, quad = lane >> 4, base = lane & 48;
  u16* Qs = (u16*)lds;
  u16* KS = (u16*)(lds + 67584);
  const float NEG = -3.0e38f;
  for (int item = blockIdx.x; item < nmt * 8; item += gridDim.x) {
    const int m0 = (item >> 3) * 128, h = item & 7;
    const u16* Wt = (const u16*)(p.ws + OFF_WQ) + ((size_t)li * 2048 + h * 256) * 1024;
    gemm_tile<128, 256, 1, 4>(lds, 1024,
      [&](int row, int k) { return *(const uint4*)(XN + (size_t)(m0 + row) * 1024 + k); },
      [&](int row, int k) { return *(const uint4*)(Wt + (size_t)row * 1024 + k); },
      [&](int mrow, int ncol, f32x4 a) {
#pragma unroll
        for (int r = 0; r < 4; ++r) Qs[(mrow + r) * 264 + ncol] = f2bf(a[r]);
      });
#pragma unroll 1
    for (int mt = 0; mt < 2; ++mt) {
    float sv[2][4]; int si[2][4];
#pragma unroll
    for (int pp = 0; pp < 2; ++pp) {
      const u16* keys = (const u16*)(p.ws + OFF_KEYS) + ((size_t)((li * 8 + h) * 2 + pp) * 128) * 128;
      f32x4 s[8];
#pragma unroll
      for (int j = 0; j < 8; ++j) s[j] = (f32x4){0.f, 0.f, 0.f, 0.f};
#pragma unroll
      for (int hf = 0; hf < 2; ++hf) {
        __syncthreads();
#pragma unroll
        for (int i = 0; i < 4; ++i) { const int id = tid + 256 * i; *(uint4*)(KS + (id >> 4) * 136 + (id & 15) * 8) = *(const uint4*)(keys + (size_t)(hf * 64 + (id >> 4)) * 128 + (id & 15) * 8); }
        __syncthreads();
#pragma unroll
        for (int ks = 0; ks < 4; ++ks) {
          const bf16x8 af = *(const bf16x8*)(Qs + (wave * 32 + mt * 16 + c) * 264 + pp * 128 + ks * 32 + quad * 8);
#pragma unroll
          for (int j = 0; j < 4; ++j) s[hf * 4 + j] = mfma16(af, *(const bf16x8*)(KS + (j * 16 + c) * 136 + ks * 32 + quad * 8), s[hf * 4 + j]);
        }
      }
      unsigned key[8][4];
#pragma unroll
      for (int j = 0; j < 8; ++j)
#pragma unroll
        for (int r = 0; r < 4; ++r) key[j][r] = (fkey(s[j][r]) & ~0x7Fu) | (unsigned)(127 - (j * 16 + c));
      unsigned kept[4] = {0u, 0u, 0u, 0u};
#pragma unroll 1
      for (int k = 0; k < 16; ++k) {
#pragma unroll
        for (int r = 0; r < 4; ++r) {
          unsigned m = max(max(max(key[0][r], key[1][r]), max(key[2][r], key[3][r])), max(max(key[4][r], key[5][r]), max(key[6][r], key[7][r])));
          m = umax16(m);
          if (c == k) kept[r] = m;
#pragma unroll
          for (int j = 0; j < 8; ++j) key[j][r] = (key[j][r] == m) ? 0u : key[j][r];
        }
      }
#pragma unroll
      for (int r = 0; r < 4; ++r) { sv[pp][r] = funkey(kept[r] & ~0x7Fu); si[pp][r] = 127 - (int)(kept[r] & 0x7Fu); }
    }
    int* EIDX = (int*)(p.ws + OFF_EIDX);
    float* GATE = (float*)(p.ws + OFF_GATE);
    unsigned ck[4][16];
#pragma unroll
    for (int r = 0; r < 4; ++r)
#pragma unroll
      for (int i = 0; i < 16; ++i) {
        const float a = __shfl(sv[0][r], base + i);
        ck[r][i] = ((i + 1) * (c + 1) <= 16) ? ((fkey(a + sv[1][r]) & ~0xFFu) | (unsigned)(255 - (i * 16 + c))) : 0u;
      }
    float tv[4]; int te[4];
#pragma unroll
    for (int r = 0; r < 4; ++r) { tv[r] = 0.f; te[r] = 0; }
#pragma unroll 1
    for (int k = 0; k < 16; ++k) {
#pragma unroll
      for (int r = 0; r < 4; ++r) {
        unsigned m = ck[r][0];
#pragma unroll
        for (int i = 1; i < 16; ++i) m = max(m, ck[r][i]);
        m = umax16(m);
        const int bf = 255 - (int)(m & 0xFFu);
        const int wi = bf >> 4, wj = bf & 15;
        const int e0 = __shfl(si[0][r], base + wi), e1 = __shfl(si[1][r], base + wj);
        if (c == k) { tv[r] = funkey(m & ~0xFFu); te[r] = e0 * 128 + e1; }
#pragma unroll
        for (int i = 0; i < 16; ++i) ck[r][i] = (ck[r][i] == m) ? 0u : ck[r][i];
      }
    }
#pragma unroll
    for (int r = 0; r < 4; ++r) {
      const float mx = __shfl(tv[r], base);
      const float e = __expf(tv[r] - mx);
      const float sum = sum16(e);
      const int tok = m0 + wave * 32 + mt * 16 + quad * 4 + r;
      EIDX[(size_t)tok * 128 + h * 16 + c] = te[r];
      GATE[(size_t)tok * 128 + h * 16 + c] = e / sum;
    }
    }
  }
}

template <bool DRY>
DEV void phaseD4(const Params& p, int li, unsigned char* lds) {
  const int ntok = (li == 0) ? TT : TLAT;
  const int tid_ = opaque_tid(); const int lane = tid_ & 63, wave = tid_ >> 6;
  const unsigned char* PUb = p.ws + OFF_PUB;
  const unsigned char* PVb = PUb + (size_t)16384 * 1024;
  u16* XN = (u16*)(p.ws + OFF_XN);
  for (int item = blockIdx.x; item < ntok / 4; item += gridDim.x) {
    const int tok = item * 4 + wave;
    f32x2 hv2[8];
    {
      const uint4 h0 = *(const uint4*)(XN + (size_t)tok * 1024 + lane * 16), h1 = *(const uint4*)(XN + (size_t)tok * 1024 + lane * 16 + 8);
      float hv[16];
      unpack8(h0, hv); unpack8(h1, hv + 8);
#pragma unroll
      for (int j = 0; j < 8; ++j) hv2[j] = (f32x2){hv[2 * j], hv[2 * j + 1]};
    }
    const int* EI = (const int*)(p.ws + OFF_EIDX) + (size_t)tok * 128;
    const float* GT = (const float*)(p.ws + OFF_GATE) + (size_t)tok * 128;
    const int ei0 = EI[lane], ei1 = EI[64 + lane];
    const float g0 = GT[lane], g1 = GT[64 + lane];
    f32x2 out2[8];
#pragma unroll
    for (int j = 0; j < 8; ++j) out2[j] = (f32x2){0.f, 0.f};
    uint4 ua[8], va[8];
    int e[8]; float gg[8];
#pragma unroll
    for (int u = 0; u < 8; ++u) { e[u] = __shfl(ei0, u); gg[u] = __shfl(g0, u); }
#pragma unroll
    for (int u = 0; u < 8; ++u) { ua[u] = *(const uint4*)(PUb + (size_t)e[u] * 1024 + lane * 16); }
#pragma unroll 1
    for (int i = 0; i < 128; i += 8) {
      float dot[8];
#pragma unroll
      for (int u = 0; u < 8; ++u) { va[u] = *(const uint4*)(PVb + (size_t)e[u] * 1024 + lane * 16); }
#pragma unroll
      for (int u = 0; u < 8; ++u) {
        const unsigned uw[4] = {ua[u].x, ua[u].y, ua[u].z, ua[u].w};
        f32x2 da = (f32x2){0.f, 0.f}, db = da;
#pragma unroll
        for (int q4 = 0; q4 < 4; ++q4) {
          da += __builtin_amdgcn_cvt_pk_f32_fp8((int)uw[q4], false) * hv2[2 * q4];
          db += __builtin_amdgcn_cvt_pk_f32_fp8((int)uw[q4], true) * hv2[2 * q4 + 1];
        }
        da += db;
        dot[u] = (da.x + da.y) * (1.f / PEER_USCALE);
      }
      float gcur[8];
#pragma unroll
      for (int u = 0; u < 8; ++u) gcur[u] = gg[u];
      if (i + 8 < 128) {
#pragma unroll
        for (int u = 0; u < 8; ++u) {
          const int ii = i + 8 + u;
          e[u] = (ii < 64) ? __shfl(ei0, ii) : __shfl(ei1, ii - 64);
          gg[u] = (ii < 64) ? __shfl(g0, ii) : __shfl(g1, ii - 64);
        }
#pragma unroll
        for (int u = 0; u < 8; ++u) { ua[u] = *(const uint4*)(PUb + (size_t)e[u] * 1024 + lane * 16); }
      }
#pragma unroll
      for (int u = 0; u < 8; ++u) dot[u] = wave_sum(dot[u]);
      {
        float mine = dot[0];
#pragma unroll
        for (int u = 1; u < 8; ++u) mine = ((lane & 7) == u) ? dot[u] : mine;
        const float act = 0.5f * mine * (1.f + erff(mine * 0.70710678118654752f));
#pragma unroll
        for (int u = 0; u < 8; ++u) dot[u] = __int_as_float(__builtin_amdgcn_readlane(__float_as_int(act), u)) * gcur[u] * (1.f / PEER_VSCALE);
      }
#pragma unroll
      for (int u = 0; u < 8; ++u) {
        const unsigned vw[4] = {va[u].x, va[u].y, va[u].z, va[u].w};
        const f32x2 a2 = (f32x2){dot[u], dot[u]};
#pragma unroll
        for (int q4 = 0; q4 < 4; ++q4) {
          out2[2 * q4] += a2 * __builtin_amdgcn_cvt_pk_f32_fp8((int)vw[q4], false);
          out2[2 * q4 + 1] += a2 * __builtin_amdgcn_cvt_pk_f32_fp8((int)vw[q4], true);
        }
      }
    }
    float out[16];
#pragma unroll
    for (int j = 0; j < 8; ++j) { out[2 * j] = out2[j].x; out[2 * j + 1] = out2[j].y; }
    const int mv = tok_mv(tok);
    const float* gf = modp(p, li, mv, 5) + lane * 16;
    float* xr = xdst(p, tok) + lane * 16;
    float xv[16]; float ss = 0.f;
#pragma unroll
    for (int j = 0; j < 4; ++j) {
      float4 x = *(const float4*)(xr + j * 4);
      const float4 g = *(const float4*)(gf + j * 4);
      x.x += g.x * out[j * 4]; x.y += g.y * out[j * 4 + 1]; x.z += g.z * out[j * 4 + 2]; x.w += g.w * out[j * 4 + 3];
      if (!DRY) *(float4*)(xr + j * 4) = x;
      xv[j * 4] = x.x; xv[j * 4 + 1] = x.y; xv[j * 4 + 2] = x.z; xv[j * 4 + 3] = x.w;
      ss += x.x * x.x + x.y * x.y + x.z * x.z + x.w * x.w;
    }
    if (DRY) { if (lane == 0) ((float*)(p.ws + OFF_G))[tok] = ss; }
    else if (li == 0) {
      ss = wave_sum(ss);
      const float rstd = rsqrtf(ss * (1.f / 1024.f) + 1e-6f);
      const float* gain = p.in[I_MIXNORM] + 1024 + lane * 16;
      const float* sc = modp(p, 1, mv, 1) + lane * 16;
      const float* sh = modp(p, 1, mv, 0) + lane * 16;
      float o[16];
#pragma unroll
      for (int j = 0; j < 16; ++j) o[j] = xv[j] * rstd * gain[j] * (1.f + sc[j]) + sh[j];
      *(uint4*)(XN + (size_t)tok * 1024 + lane * 16) = pack8(o);
      *(uint4*)(XN + (size_t)tok * 1024 + lane * 16 + 8) = pack8(o + 8);
    }
  }
}

DEV void dump_bf(const Params& p, size_t o0, size_t n0, size_t o1, size_t n1, size_t o2, size_t n2, size_t o3, size_t n3) {
  const size_t Q = 8388608;
  for (size_t i = (size_t)blockIdx.x * 256 + threadIdx.x; i < 4 * Q; i += (size_t)gridDim.x * 256) {
    const int q = (int)(i / Q); const size_t j = i % Q;
    const size_t off = q == 0 ? o0 : q == 1 ? o1 : q == 2 ? o2 : o3;
    const size_t n = q == 0 ? n0 : q == 1 ? n1 : q == 2 ? n2 : n3;
    const size_t stride = (DIAG == 15) ? (n / Q > 2 ? n / Q : 2) : (n / Q > 0 ? n / Q : 1);
    const size_t idx = j * stride;
    p.out[i] = idx < n ? bf2f(((const u16*)(p.ws + off))[idx]) : 0.f;
  }
}
DEV void grid_barrier(const Params& p, int k) {
  asm volatile("s_waitcnt vmcnt(0)" ::: "memory");
  if (k == 0 || (gridDim.x & 7) != 0) {
    cg::this_grid().sync();
  } else {
    __syncthreads();
    if (threadIdx.x == 0) {
      unsigned* bar = (unsigned*)(p.ws + OFF_BAR);
      const unsigned gsz = gridDim.x >> 3, g = blockIdx.x & 7;
      __builtin_amdgcn_fence(__ATOMIC_RELEASE, "agent");
      const unsigned old = __hip_atomic_fetch_add(bar + g * 64, 1u, __ATOMIC_RELAXED, __HIP_MEMORY_SCOPE_AGENT);
      if (old == (unsigned)k * gsz - 1u) __hip_atomic_fetch_add(bar + 8 * 64, 1u, __ATOMIC_RELAXED, __HIP_MEMORY_SCOPE_AGENT);
      while (__hip_atomic_load(bar + 8 * 64, __ATOMIC_RELAXED, __HIP_MEMORY_SCOPE_AGENT) < (unsigned)k * 8u) __builtin_amdgcn_s_sleep(1);
    }
    __syncthreads();
  }
  __builtin_amdgcn_fence(__ATOMIC_ACQUIRE, "agent");
}
#define PH(K, CALL) if (ph_lo <= (K) && (K) < ph_hi) { CALL; if ((K) + 1 < ph_hi) grid_barrier(p, bar_k++); }
__global__ void __launch_bounds__(256, 1) mega(Params p, int ph_lo, int ph_hi) {
  __shared__ __attribute__((aligned(16))) unsigned char lds[LDS_BYTES];
  int bar_k = 0;
#if DIAG == 9
  { uint4* q = (uint4*)(p.ws + OFF_XCTX); const size_t n = (WS_END - OFF_XCTX) / 16;
    for (size_t i = (size_t)blockIdx.x * 256 + threadIdx.x; i < n; i += (size_t)gridDim.x * 256) q[i] = make_uint4(0xAAAAAAAAu, 0xAAAAAAAAu, 0xAAAAAAAAu, 0xAAAAAAAAu);
    cg::this_grid().sync(); }
#endif
  PH(0, phase0a(p, lds))
  PH(1, norm_pass(p, 0, true, p.in[I_MIXNORM], 1, 0, TT))
#if PROBE_AB == 1
  PH(2, (phaseA(p, 0, lds), phaseA(p, 0, lds)))
#else
  PH(2, phaseA(p, 0, lds))
#endif
#if PROBE_AB == 2
  PH(3, (phaseB(p, 0, lds), phaseB(p, 0, lds)))
#else
  PH(3, phaseB(p, 0, lds))
#endif
#if DIAG == 1
  PH(4, dump_bf(p, OFF_QB, 53477376ull, OFF_HYIN, 26738688ull, OFF_G, 26738688ull, OFF_PRW, 49020928ull))
#elif DIAG == 15
  PH(4, dump_bf(p, OFF_HF + 2, 17825790ull, OFF_TW + 2, 16382ull, OFF_H2 + 2, 1114110ull, OFF_ATT, 0ull))
#elif DIAG == 11
  PH(4, dump_bf(p, OFF_PRW + 2 * (49020928ull - 8388608ull), 8388608ull, OFF_PMH + 2 * (41222144ull - 8388608ull), 8388608ull, OFF_QB + 2 * (53477376ull - 8388608ull), 8388608ull, OFF_G + 2 * (26738688ull - 8388608ull), 8388608ull))
#elif DIAG == 2
  PH(4, dump_bf(p, OFF_PRW, 49020928ull, OFF_PMH, 41222144ull, OFF_XN, 35651584ull, OFF_WIN, 5505024ull))
#else
#if PROBE_C
  PH(4, (phaseC(p, 0, lds, 2, PROBE_C), phaseC(p, 0, lds)))
#else
  PH(4, phaseC(p, 0, lds))
#endif
#endif
#if DIAG == 3
  PH(5, dump_bf(p, OFF_ATT, 13369344ull, OFF_HYO, 8912896ull, OFF_Y0, 13369344ull, OFF_Y1, 13369344ull))
#elif DIAG == 12
  PH(5, dump_bf(p, OFF_ATT + 2 * 8388608ull, 4980736ull, OFF_ATT, 0ull, OFF_ATT, 0ull, OFF_ATT, 0ull))
#elif DIAG == 13
  PH(5, dump_bf(p, OFF_Y0 + 2 * 8388608ull, 4980736ull, OFF_Y1 + 2 * 8388608ull, 4980736ull, OFF_ATT, 0ull, OFF_ATT, 0ull))
#elif DIAG == 14
  PH(5, dump_bf(p, OFF_HYO, 8388608ull, OFF_HYO + 2 * 8388608ull, 524288ull, OFF_ATT, 0ull, OFF_ATT, 0ull))
#elif DIAG == 10
  PH(5, dump_bf(p, OFF_ATT + 2 * 4980736ull, 8388608ull, OFF_HYO + 2 * 524288ull, 8388608ull, OFF_Y0 + 2 * 4980736ull, 8388608ull, OFF_Y1 + 2 * 4980736ull, 8388608ull))
#else
#if PROBE_AB == 3
  PH(5, (phaseD1(p, 0, lds), phaseD1(p, 0, lds)))
#else
  PH(5, (phaseD0(p, 0), grid_barrier(p, bar_k++), phaseD1(p, 0, lds)))
#endif
#endif
  PH(6, (norm_pass(p, 0, false, p.in[I_FFNNORM], 4, 3, TT), cvt_peer(p, 0)))
#if PROBE_D3
  PH(7, (phaseD3(p, 0, lds), phaseD3(p, 0, lds)))
#else
  PH(7, phaseD3(p, 0, lds))
#endif
#if PROBE_D4
  PH(8, (phaseD4<true>(p, 0, lds), phaseD4<false>(p, 0, lds)))
#else
  PH(8, phaseD4<false>(p, 0, lds))
#endif
  PH(9, phaseA(p, 1, lds))
  PH(10, phaseB(p, 1, lds))
  PH(11, phaseC(p, 1, lds))
  PH(12, (phaseD0(p, 1), grid_barrier(p, bar_k++), phaseD1(p, 1, lds)))
  PH(13, (norm_pass(p, 1, false, p.in[I_FFNNORM] + 1024, 4, 3, TLAT), cvt_peer(p, 1)))
  PH(14, phaseD3(p, 1, lds))
  PH(15, phaseD4<false>(p, 1, lds))
}

extern "C" void kernel_launch(void* const* d_in, const int* in_sizes, int n_in, void* d_out, int out_size, void* d_ws, size_t ws_size, hipStream_t stream) {
  static int grid_blocks = 0;
  if (!grid_blocks) {
    int dev = 0, cus = 0, per_cu = 0;
    hipGetDevice(&dev);
    hipDeviceGetAttribute(&cus, hipDeviceAttributeMultiprocessorCount, dev);
    hipOccupancyMaxActiveBlocksPerMultiprocessor(&per_cu, mega, 256, 0);
    if (per_cu > GRID_BLOCKS_PER_CU) per_cu = GRID_BLOCKS_PER_CU;
    if (per_cu < 1) per_cu = 1;
    grid_blocks = cus * per_cu;
  }
  if (n_in != N_IN || ws_size < WS_NEED) { fprintf(stderr, "kernel_launch: bad inputs n_in=%d ws=%zu need %zu\n", n_in, ws_size, (size_t)WS_NEED); return; }
  Params p{};
  for (int i = 0; i < N_IN; ++i) p.in[i] = (const float*)d_in[i];
  p.out = (float*)d_out; p.ws = (unsigned char*)d_ws;
#if MULTI_LAUNCH
  for (int ph = 0; ph < NPH; ++ph) hipLaunchKernelGGL(mega, dim3(grid_blocks), dim3(256), 0, stream, p, ph, ph + 1);
#else
  int lo = 0, hi = NPH;
  void* args[] = {&p, &lo, &hi};
  hipError_t e = hipLaunchCooperativeKernel((void*)mega, dim3(grid_blocks), dim3(256), args, 0, stream);
  if (e != hipSuccess) fprintf(stderr, "cooperative launch failed: %s (grid %d)\n", hipGetErrorString(e), grid_blocks);
#endif
}
```

```cpp
#include <hip/hip_runtime.h>
#include <hip/hip_cooperative_groups.h>
#include <cstdio>
namespace cg = cooperative_groups;

#ifndef DIAG
#define DIAG 0
#endif
#ifndef PROBE_D4
#define PROBE_D4 0
#endif
#ifndef PROBE_D3
#define PROBE_D3 0
#endif
#ifndef PROBE_AB
#define PROBE_AB 0
#endif
#ifndef PROBE_C
#define PROBE_C 0
#endif
#ifndef MULTI_LAUNCH
#define MULTI_LAUNCH 0
#endif

typedef unsigned short u16;
typedef __attribute__((ext_vector_type(8))) short bf16x8;
typedef __attribute__((ext_vector_type(4))) float f32x4;
typedef __attribute__((ext_vector_type(2))) float f32x2;
#define DEV __device__ __forceinline__

constexpr int D = 1024, TLAT = 32768, TCTX = 2048, TT = 34816, KTOT = 4352;
constexpr int NPH = 16;
constexpr int LDS_BYTES = 98304 + 256;
constexpr int GRID_BLOCKS_PER_CU = 2;

enum { I_X = 0, I_C, I_CTX, I_CCTX, I_MODW, I_MODB, I_MIXNORM, I_WIN, I_WOUT, I_RWCONV, I_RWDUP, I_RWD0, I_RWAUP, I_RWA0,
       I_RWGUP, I_RWKK, I_RWKA, I_RWRK, I_RWGNG, I_RWGNB, I_MQNORM, I_MWUQ, I_MKVNORM, I_MWUKV, I_MQGAIN, I_MKGAIN,
       I_HYCONV, I_HYW1, I_HYB1, I_HYF1, I_HYW2, I_HYB2, I_HYF2, I_HYW3, I_HYB3, I_HYBIAS, I_FFNNORM, I_PWQ, I_PKEYS, I_PU, I_PV, N_IN };

struct Params { const float* in[N_IN]; float* out; unsigned char* ws; };

constexpr size_t OFF_CTR  = 0;
constexpr size_t OFF_WIN  = 256;
constexpr size_t OFF_WOUT = OFF_WIN  + 2ull * 2688 * 1024 * 2;
constexpr size_t OFF_WQ   = OFF_WOUT + 2ull * 1024 * 1024 * 2;
constexpr size_t OFF_WUQ  = OFF_WQ   + 2ull * 2048 * 1024 * 2;
constexpr size_t OFF_WUKV = OFF_WUQ  + 2ull * 576 * 256 * 2;
constexpr size_t OFF_DUT  = OFF_WUKV + 2ull * 768 * 128 * 2;
constexpr size_t OFF_AUT  = OFF_DUT  + 4ull * 384 * 64 * 2;
constexpr size_t OFF_GUT  = OFF_AUT  + 4ull * 384 * 64 * 2;
constexpr size_t OFF_KEYS = OFF_GUT  + 2ull * 384 * 128 * 2;
constexpr size_t OFF_MOD  = OFF_KEYS + 2ull * 8 * 2 * 128 * 128 * 2;
constexpr size_t OFF_H2   = OFF_MOD  + 2ull * 9 * 6144 * 4;
constexpr size_t OFF_TW   = OFF_H2   + 2ull * 4352 * 64 * 4;
constexpr size_t OFF_ROPE = OFF_TW   + 4096ull * 8;
constexpr size_t OFF_HF   = OFF_ROPE + 2ull * 4096 * 16 * 4;
constexpr size_t OFF_XCTX = OFF_HF   + 2ull * 256 * 8192 * 8 + 2ull * 256 * 512 * 8;
constexpr size_t OFF_PRW  = OFF_XCTX + 2048ull * 1024 * 4;
constexpr size_t OFF_PMH  = OFF_PRW  + (size_t)TT * 1408 * 2;
constexpr size_t OFF_ATT  = OFF_PMH;
constexpr size_t OFF_HYO  = OFF_ATT  + (size_t)TT * 384 * 2;
constexpr size_t OFF_Y0   = OFF_HYO  + (size_t)TT * 256 * 2;
constexpr size_t OFF_QB   = OFF_PMH  + (size_t)TT * 1184 * 2;
constexpr size_t OFF_KB   = OFF_QB   + 48ull * KTOT * 96 * 2;
constexpr size_t OFF_VT   = OFF_KB   + 48ull * KTOT * 96 * 2;
constexpr size_t OFF_XN   = OFF_QB;
constexpr size_t OFF_EIDX = OFF_XN   + (size_t)TT * 1024 * 2;
constexpr size_t OFF_GATE = OFF_EIDX + (size_t)TT * 128 * 4;
constexpr size_t OFF_HYIN = OFF_VT   + 48ull * 64 * KTOT * 2;
constexpr size_t OFF_G    = OFF_HYIN + 3ull * TT * 256 * 2;
constexpr size_t OFF_BG   = OFF_G    + (size_t)TT * 384 * 2;
constexpr size_t OFF_Y1   = OFF_BG   + (size_t)TT * 384 * 2;
constexpr size_t WS_END   = OFF_Y1   + (size_t)TT * 384 * 2;
static_assert(OFF_GATE + (size_t)TT * 128 * 4 <= OFF_HYIN, "alias overflow");
static_assert(OFF_Y0 + (size_t)TT * 384 * 2 <= OFF_QB, "alias overflow 2");
constexpr size_t OFF_BAR = WS_END;
constexpr size_t WS_NEED = WS_END + 4096;
static_assert(WS_NEED <= 536870912ull, "workspace too large");

DEV u16 f2bf(float f) { unsigned r; asm("v_cvt_pk_bf16_f32 %0, %1, %1" : "=v"(r) : "v"(f)); return (u16)(r & 0xffffu); }
DEV float bf2f(u16 h) { return __uint_as_float(((unsigned)h) << 16); }
DEV unsigned pack2(float a, float b) { unsigned r; asm("v_cvt_pk_bf16_f32 %0, %1, %2" : "=v"(r) : "v"(a), "v"(b)); return r; }
DEV float lo2f(unsigned u) { return __uint_as_float(u << 16); }
DEV float hi2f(unsigned u) { return __uint_as_float(u & 0xffff0000u); }
DEV uint4 pack8(const float* f) { uint4 r; r.x = pack2(f[0], f[1]); r.y = pack2(f[2], f[3]); r.z = pack2(f[4], f[5]); r.w = pack2(f[6], f[7]); return r; }
DEV void unpack8(uint4 v, float* f) { f[0] = lo2f(v.x); f[1] = hi2f(v.x); f[2] = lo2f(v.y); f[3] = hi2f(v.y); f[4] = lo2f(v.z); f[5] = hi2f(v.z); f[6] = lo2f(v.w); f[7] = hi2f(v.w); }
DEV float sigmoidf_(float x) { return 1.f / (1.f + __expf(-x)); }

template <int CTRL> DEV float dppf(float x) { return __int_as_float(__builtin_amdgcn_update_dpp(0, __float_as_int(x), CTRL, 0xf, 0xf, false)); }
template <int CTRL> DEV int dppi(int x) { return __builtin_amdgcn_update_dpp(0, x, CTRL, 0xf, 0xf, false); }
DEV float sum4(float v) { v += dppf<0xB1>(v); v += dppf<0x4E>(v); return v; }
DEV float sum8(float v) { v = sum4(v); v += dppf<0x141>(v); return v; }
DEV float sum16(float v) { v = sum8(v); v += dppf<0x140>(v); return v; }
DEV float wave_sum(float v) { v = sum16(v); v += __shfl_xor(v, 16); v += __shfl_xor(v, 32); return v; }
DEV bf16x8 as_bf8(uint4 v) { union { uint4 u; bf16x8 b; } x; x.u = v; return x.b; }
DEV f32x4 mfma16(bf16x8 a, bf16x8 b, f32x4 c) { return __builtin_amdgcn_mfma_f32_16x16x32_bf16(a, b, c, 0, 0, 0); }
DEV float dot2bf(unsigned a, unsigned b, float c) { asm("v_dot2c_f32_bf16 %0, %1, %2" : "+v"(c) : "v"(a), "v"(b)); return c; }
DEV float fsin(float x) { return __builtin_amdgcn_sinf(x * 0.15915494309189535f); }
DEV float fcos(float x) { return __builtin_amdgcn_cosf(x * 0.15915494309189535f); }

DEV int opaque_tid() { int t = threadIdx.x; asm volatile("" : "+v"(t)); return t; }
DEV int tok_mv(int tok) { return tok < TLAT ? (tok >> 12) : 8; }
DEV const float* xsrc(const Params& p, int tok, bool orig) {
  if (tok < TLAT) return (orig ? p.in[I_X] : p.out) + (size_t)tok * D;
  return (orig ? p.in[I_CTX] : (const float*)(p.ws + OFF_XCTX)) + (size_t)(tok - TLAT) * D;
}
DEV float* xdst(const Params& p, int tok) {
  if (tok < TLAT) return p.out + (size_t)tok * D;
  return (float*)(p.ws + OFF_XCTX) + (size_t)(tok - TLAT) * D;
}
DEV const float* modp(const Params& p, int li, int mv, int chunk) { return (const float*)(p.ws + OFF_MOD) + ((size_t)(li * 9 + mv) * 6 + chunk) * 1024; }

DEV void conv8(const u16* P, int ld, int tok, bool hp, bool hn, int col, const float* cw, int cwld, float* out) {
  const u16* r = P + (size_t)tok * ld + col;
  uint4 z = make_uint4(0, 0, 0, 0);
  uint4 v1 = *(const uint4*)r;
  uint4 v0 = hp ? *(const uint4*)(r - ld) : z;
  uint4 v2 = hn ? *(const uint4*)(r + ld) : z;
  float a[8], b[8], c[8];
  unpack8(v0, a); unpack8(v1, b); unpack8(v2, c);
  float4 w0a = *(const float4*)(cw), w0b = *(const float4*)(cw + 4);
  float4 w1a = *(const float4*)(cw + cwld), w1b = *(const float4*)(cw + cwld + 4);
  float4 w2a = *(const float4*)(cw + 2 * cwld), w2b = *(const float4*)(cw + 2 * cwld + 4);
  const float w0[8] = {w0a.x, w0a.y, w0a.z, w0a.w, w0b.x, w0b.y, w0b.z, w0b.w};
  const float w1[8] = {w1a.x, w1a.y, w1a.z, w1a.w, w1b.x, w1b.y, w1b.z, w1b.w};
  const float w2[8] = {w2a.x, w2a.y, w2a.z, w2a.w, w2b.x, w2b.y, w2b.z, w2b.w};
#pragma unroll
  for (int j = 0; j < 8; ++j) out[j] = a[j] * w0[j] + b[j] * w1[j] + c[j] * w2[j];
}
DEV void tok_nb(int tok, bool& hp, bool& hn) {
  if (tok < TLAT) { int t = tok & 4095; hp = t > 0; hn = t < 4095; }
  else { int t = (tok - TLAT) & 255; hp = t > 0; hn = t < 255; }
}

template <int BM, int BN, int WM, int WN, class AL, class BL, class EP>
DEV void gemm_tile(unsigned char* lds, int K, AL aload, BL bload, EP epi) {
  constexpr int LDT = 72;
  constexpr int TM = BM / WM / 16, TN = BN / WN / 16;
  constexpr int NA = BM * 8 / 256, NBc = BN * 8 / 256;
  u16* As = (u16*)lds;
  u16* Bs = As + BM * LDT;
  const int tid = opaque_tid(), lane = tid & 63, wave = tid >> 6;
  const int wm = wave / WN, wn = wave % WN;
  const int c = lane & 15, quad = lane >> 4;
  f32x4 acc[TM][TN];
#pragma unroll
  for (int i = 0; i < TM; ++i)
#pragma unroll
    for (int j = 0; j < TN; ++j) acc[i][j] = (f32x4){0.f, 0.f, 0.f, 0.f};
  uint4 ra[NA], rb[NBc];
#pragma unroll
  for (int i = 0; i < NA; ++i) { int id = tid + 256 * i; ra[i] = aload(id >> 3, (id & 7) * 8); }
#pragma unroll
  for (int i = 0; i < NBc; ++i) { int id = tid + 256 * i; rb[i] = bload(id >> 3, (id & 7) * 8); }
  const int nk = K / 64;
  for (int kt = 0; kt < nk; ++kt) {
    __syncthreads();
#pragma unroll
    for (int i = 0; i < NA; ++i) { int id = tid + 256 * i; *(uint4*)(As + (id >> 3) * LDT + (id & 7) * 8) = ra[i]; }
#pragma unroll
    for (int i = 0; i < NBc; ++i) { int id = tid + 256 * i; *(uint4*)(Bs + (id >> 3) * LDT + (id & 7) * 8) = rb[i]; }
    __syncthreads();
    if (kt + 1 < nk) {
      const int k0 = (kt + 1) * 64;
#pragma unroll
      for (int i = 0; i < NA; ++i) { int id = tid + 256 * i; ra[i] = aload(id >> 3, k0 + (id & 7) * 8); }
#pragma unroll
      for (int i = 0; i < NBc; ++i) { int id = tid + 256 * i; rb[i] = bload(id >> 3, k0 + (id & 7) * 8); }
    }
#pragma unroll (TN >= 8 ? 1 : 2)
    for (int ks = 0; ks < 2; ++ks) {
      bf16x8 af[TM], bfr[TN];
#pragma unroll
      for (int i = 0; i < TM; ++i) af[i] = *(const bf16x8*)(As + (wm * (BM / WM) + i * 16 + c) * LDT + ks * 32 + quad * 8);
#pragma unroll
      for (int j = 0; j < TN; ++j) bfr[j] = *(const bf16x8*)(Bs + (wn * (BN / WN) + j * 16 + c) * LDT + ks * 32 + quad * 8);
#pragma unroll
      for (int i = 0; i < TM; ++i)
#pragma unroll
        for (int j = 0; j < TN; ++j) acc[i][j] = mfma16(af[i], bfr[j], acc[i][j]);
    }
  }
  __syncthreads();
#pragma unroll
  for (int i = 0; i < TM; ++i)
#pragma unroll
    for (int j = 0; j < TN; ++j) epi(wm * (BM / WM) + i * 16 + quad * 4, wn * (BN / WN) + j * 16 + c, acc[i][j]);
}

DEV void transpose_item(const float* W, int K, int N, u16* Wt, int item, unsigned char* lds, int ntn) {
  float* tile = (float*)lds;
  const int kb = item / ntn, nb = item % ntn;
  const int tid = opaque_tid();
  __syncthreads();
#pragma unroll
  for (int i = 0; i < 16; ++i) {
    int kk = i * 4 + (tid >> 6), nn = tid & 63;
    int n = nb * 64 + nn;
    tile[kk * 65 + nn] = (n < N) ? W[(size_t)(kb * 64 + kk) * N + n] : 0.f;
  }
  __syncthreads();
  const int nl = tid >> 2, kq = tid & 3;
  float f[16];
#pragma unroll
  for (int j = 0; j < 16; ++j) f[j] = tile[(kq * 16 + j) * 65 + nl];
  u16* dst = Wt + (size_t)(nb * 64 + nl) * K + kb * 64 + kq * 16;
  *(uint4*)dst = pack8(f);
  *(uint4*)(dst + 8) = pack8(f + 8);
}

DEV void phase0a(const Params& p, unsigned char* lds) {
  const int tid = opaque_tid();
  if (blockIdx.x == 0 && tid < 64) ((unsigned*)(p.ws + OFF_CTR))[tid] = 0u;
  if (blockIdx.x == 0) { for (int i = tid; i < 1024; i += 256) ((unsigned*)(p.ws + OFF_BAR))[i] = 0u; }
  constexpr int J_WIN = 2 * 16 * 42, J_WOUT = 2 * 16 * 16, J_WQ = 2 * 16 * 32, J_WUQ = 2 * 4 * 9, J_WUKV = 2 * 2 * 12,
                J_DU = 4 * 6, J_AU = 4 * 6, J_GU = 2 * 2 * 6, J_KEYS = 256, J_MOD = 192, J_H2 = 2176, J_TW = 16, J_ROPE = 256;
  constexpr int TOTAL = J_WIN + J_WOUT + J_WQ + J_WUQ + J_WUKV + J_DU + J_AU + J_GU + J_KEYS + J_MOD + J_H2 + J_TW + J_ROPE;
  for (int item = blockIdx.x; item < TOTAL; item += gridDim.x) {
    int r = item;
    if (r < J_WIN) { int li = r / 672; r %= 672; transpose_item(p.in[I_WIN] + (size_t)li * 1024 * 2592, 1024, 2592, (u16*)(p.ws + OFF_WIN) + (size_t)li * 2688 * 1024, r, lds, 42); continue; } r -= J_WIN;
    if (r < J_WOUT) { int li = r / 256; r %= 256; transpose_item(p.in[I_WOUT] + (size_t)li * 1024 * 1024, 1024, 1024, (u16*)(p.ws + OFF_WOUT) + (size_t)li * 1024 * 1024, r, lds, 16); continue; } r -= J_WOUT;
    if (r < J_WQ) { int li = r / 512; r %= 512; transpose_item(p.in[I_PWQ] + (size_t)li * 1024 * 2048, 1024, 2048, (u16*)(p.ws + OFF_WQ) + (size_t)li * 2048 * 1024, r, lds, 32); continue; } r -= J_WQ;
    if (r < J_WUQ) { int li = r / 36; r %= 36; transpose_item(p.in[I_MWUQ] + (size_t)li * 256 * 576, 256, 576, (u16*)(p.ws + OFF_WUQ) + (size_t)li * 576 * 256, r, lds, 9); continue; } r -= J_WUQ;
    if (r < J_WUKV) { int li = r / 24; r %= 24; transpose_item(p.in[I_MWUKV] + (size_t)li * 128 * 768, 128, 768, (u16*)(p.ws + OFF_WUKV) + (size_t)li * 768 * 128, r, lds, 12); continue; } r -= J_WUKV;
    if (r < J_DU) { int m = r / 6; r %= 6; transpose_item(p.in[I_RWDUP] + (size_t)m * 64 * 384, 64, 384, (u16*)(p.ws + OFF_DUT) + (size_t)m * 384 * 64, r, lds, 6); continue; } r -= J_DU;
    if (r < J_AU) { int m = r / 6; r %= 6; transpose_item(p.in[I_RWAUP] + (size_t)m * 64 * 384, 64, 384, (u16*)(p.ws + OFF_AUT) + (size_t)m * 384 * 64, r, lds, 6); continue; } r -= J_AU;
    if (r < J_GU) { int li = r / 12; r %= 12; transpose_item(p.in[I_RWGUP] + (size_t)li * 128 * 384, 128, 384, (u16*)(p.ws + OFF_GUT) + (size_t)li * 384 * 128, r, lds, 6); continue; } r -= J_GU;
    if (r < J_KEYS) {
      const float* src = p.in[I_PKEYS] + (size_t)r * 2048 + tid * 8;
      float4 a = *(const float4*)src, b = *(const float4*)(src + 4);
      float f[8] = {a.x, a.y, a.z, a.w, b.x, b.y, b.z, b.w};
      *(uint4*)((u16*)(p.ws + OFF_KEYS) + (size_t)r * 2048 + tid * 8) = pack8(f);
      continue;
    } r -= J_KEYS;
    if (r < J_MOD) {
      const int li = r / 96, n0 = (r % 96) * 64;
      float* sc = (float*)lds;
      float* red = sc + 9 * 1024;
      __syncthreads();
      for (int i = tid; i < 9 * 1024; i += 256) {
        int mv = i >> 10, k = i & 1023;
        float v = (mv < 8) ? p.in[I_C][mv * 1024 + k] : p.in[I_CCTX][k];
        sc[i] = v * sigmoidf_(v);
      }
      __syncthreads();
      const int lane = tid & 63, wave = tid >> 6;
      float acc[9];
#pragma unroll
      for (int m = 0; m < 9; ++m) acc[m] = 0.f;
      const float* w = p.in[I_MODW] + (size_t)li * 1024 * 6144 + n0 + lane;
#pragma unroll 16
      for (int k = wave * 256; k < wave * 256 + 256; ++k) {
        float wv = w[(size_t)k * 6144];
#pragma unroll
        for (int m = 0; m < 9; ++m) acc[m] += sc[m * 1024 + k] * wv;
      }
#pragma unroll
      for (int m = 0; m < 9; ++m) red[(wave * 9 + m) * 64 + lane] = acc[m];
      __syncthreads();
      for (int i = tid; i < 9 * 64; i += 256) {
        int m = i >> 6, l = i & 63;
        float s = red[(0 * 9 + m) * 64 + l] + red[(1 * 9 + m) * 64 + l] + red[(2 * 9 + m) * 64 + l] + red[(3 * 9 + m) * 64 + l];
        ((float*)(p.ws + OFF_MOD))[(size_t)(li * 9 + m) * 6144 + n0 + l] = s + p.in[I_MODB][li * 6144 + n0 + l];
      }
      continue;
    } r -= J_MOD;
    if (r < J_H2) {
      const int li = r / 1088; const int q4 = r % 1088;
      const int tl = tid >> 6, j = tid & 63;
      const int row = q4 * 4 + tl;
      const float tn = row < 4096 ? (float)row / 4096.f : (float)(row - 4096) / 256.f;
      float* h1s = (float*)lds;
      __syncthreads();
      const float* w1 = p.in[I_HYW1] + (size_t)li * 33 * 64;
      float a = tn * w1[j];
#pragma unroll 4
      for (int k = 1; k <= 16; ++k) {
        float rev = tn * (float)k;
        a += __builtin_amdgcn_cosf(rev) * w1[k * 64 + j] + __builtin_amdgcn_sinf(rev) * w1[(16 + k) * 64 + j];
      }
      a = fsin(p.in[I_HYF1][li * 64 + j] * (a + p.in[I_HYB1][li * 64 + j]));
      h1s[tl * 64 + j] = a;
      __syncthreads();
      const float* w2 = p.in[I_HYW2] + (size_t)li * 64 * 64;
      float b = 0.f;
#pragma unroll 8
      for (int i = 0; i < 64; ++i) b += h1s[tl * 64 + i] * w2[i * 64 + j];
      b = fsin(p.in[I_HYF2][li * 64 + j] * (b + p.in[I_HYB2][li * 64 + j]));
      ((float*)(p.ws + OFF_H2))[((size_t)li * 4352 + row) * 64 + j] = b;
      continue;
    } r -= J_H2;
    if (r < J_TW) {
      int k = r * 256 + tid;
      float rev = (float)k / 8192.f;
      float2 w; w.x = __builtin_amdgcn_cosf(rev); w.y = -__builtin_amdgcn_sinf(rev);
      ((float2*)(p.ws + OFF_TW))[k] = w;
      continue;
    } r -= J_TW;
    {
      int e = r * 256 + tid;
      int l = e >> 4, ai = e & 15, a = ai >> 3, i = ai & 7;
      float pos = a == 0 ? (float)(l >> 6) : (float)(l & 63);
      float inv = exp2f(-(float)i * (13.287712379549449f / 8.f));
      float ang = pos * inv;
      ((float*)(p.ws + OFF_ROPE))[e] = fcos(ang);
      ((float*)(p.ws + OFF_ROPE))[65536 + e] = fsin(ang);
    }
  }
}

DEV void norm_row_store(const float* xr, const float* gain, const float* sc, const float* sh, u16* dst, int lane) {
  float4 v[4]; float ss = 0.f;
#pragma unroll
  for (int j = 0; j < 4; ++j) { v[j] = *(const float4*)(xr + j * 256 + lane * 4); ss += v[j].x * v[j].x + v[j].y * v[j].y + v[j].z * v[j].z + v[j].w * v[j].w; }
  ss = wave_sum(ss);
  const float rstd = rsqrtf(ss * (1.f / 1024.f) + 1e-6f);
#pragma unroll
  for (int j = 0; j < 4; ++j) {
    const int n = j * 256 + lane * 4;
    float4 g = *(const float4*)(gain + n), s = *(const float4*)(sc + n), h = *(const float4*)(sh + n);
    uint2 o;
    o.x = pack2(v[j].x * rstd * g.x * (1.f + s.x) + h.x, v[j].y * rstd * g.y * (1.f + s.y) + h.y);
    o.y = pack2(v[j].z * rstd * g.z * (1.f + s.z) + h.z, v[j].w * rstd * g.w * (1.f + s.w) + h.w);
    *(uint2*)(dst + n) = o;
  }
}
DEV void norm_pass(const Params& p, int li, bool orig, const float* gain, int sc_chunk, int sh_chunk, int ntok) {
  const int tid_ = opaque_tid(); const int lane = tid_ & 63, wave = tid_ >> 6;
#pragma unroll 2
  for (int item = blockIdx.x; item < ntok / 4; item += gridDim.x) {
    const int tok = item * 4 + wave;
    const int mv = tok_mv(tok);
    norm_row_store(xsrc(p, tok, orig), gain, modp(p, li, mv, sc_chunk), modp(p, li, mv, sh_chunk), (u16*)(p.ws + OFF_XN) + (size_t)tok * D, lane);
  }
}

DEV float2 cmul(float2 a, float2 b) { return make_float2(a.x * b.x - a.y * b.y, a.x * b.y + a.y * b.x); }
DEV float2* stage_tw(const Params& p, unsigned char* lds) {
  float2* TWs = (float2*)(lds + 65536);
  const float2* TWg = (const float2*)(p.ws + OFF_TW);
  const int tid = opaque_tid();
  __syncthreads();
  for (int i = tid; i < 4096; i += 256) TWs[i] = TWg[i];
  __syncthreads();
  return TWs;
}
DEV float2 cadd(float2 a, float2 b) { return make_float2(a.x + b.x, a.y + b.y); }
DEV float2 csub(float2 a, float2 b) { return make_float2(a.x - b.x, a.y - b.y); }
DEV float2 cconj(float2 a) { return make_float2(a.x, -a.y); }
DEV void fft_fwd(float2* buf, int logn, const float2* TW) {
  const int tid = opaque_tid();
  const int sh = 13 - logn, nq = 1 << (logn - 2);
  for (int s = logn - 1; s >= 1; s -= 2) {
    const int h1 = 1 << s, h2 = h1 >> 1;
#pragma unroll 2
    for (int i = tid; i < nq; i += 256) {
      const int p = i & (h2 - 1);
      const int a = ((i >> (s - 1)) << (s + 1)) + p;
      const float2 w1a = TW[(p << (logn - 1 - s)) << sh], w1b = TW[((p + h2) << (logn - 1 - s)) << sh], w2 = TW[(p << (logn - s)) << sh];
      const float2 x0 = buf[a], x1 = buf[a + h2], x2 = buf[a + h1], x3 = buf[a + h1 + h2];
      const float2 y0 = cadd(x0, x2), y2 = cmul(csub(x0, x2), w1a);
      const float2 y1 = cadd(x1, x3), y3 = cmul(csub(x1, x3), w1b);
      buf[a] = cadd(y0, y1); buf[a + h2] = cmul(csub(y0, y1), w2);
      buf[a + h1] = cadd(y2, y3); buf[a + h1 + h2] = cmul(csub(y2, y3), w2);
    }
    __syncthreads();
  }
  {
    const int nh = 1 << (logn - 1);
#pragma unroll 2
    for (int i = tid; i < nh; i += 256) {
      const float2 x = buf[2 * i], y = buf[2 * i + 1];
      buf[2 * i] = cadd(x, y); buf[2 * i + 1] = csub(x, y);
    }
    __syncthreads();
  }
}
DEV void fft_inv(float2* buf, int logn, const float2* TW) {
  const int tid = opaque_tid();
  const int sh = 13 - logn, nq = 1 << (logn - 2);
  {
    const int nh = 1 << (logn - 1);
#pragma unroll 2
    for (int i = tid; i < nh; i += 256) {
      const float2 x = buf[2 * i], y = buf[2 * i + 1];
      buf[2 * i] = cadd(x, y); buf[2 * i + 1] = csub(x, y);
    }
    __syncthreads();
  }
  for (int s = 2; s <= logn - 1; s += 2) {
    const int h1 = 1 << s, h2 = h1 >> 1;
#pragma unroll 2
    for (int i = tid; i < nq; i += 256) {
      const int p = i & (h2 - 1);
      const int a = ((i >> (s - 1)) << (s + 1)) + p;
      const float2 w1a = cconj(TW[(p << (logn - 1 - s)) << sh]), w1b = cconj(TW[((p + h2) << (logn - 1 - s)) << sh]), w2 = cconj(TW[(p << (logn - s)) << sh]);
      const float2 z0 = buf[a], z1 = buf[a + h2], z2 = buf[a + h1], z3 = buf[a + h1 + h2];
      const float2 t1 = cmul(z1, w2), t3 = cmul(z3, w2);
      const float2 y0 = cadd(z0, t1), y1 = csub(z0, t1), y2 = cadd(z2, t3), y3 = csub(z2, t3);
      const float2 u2 = cmul(y2, w1a), u3 = cmul(y3, w1b);
      buf[a] = cadd(y0, u2); buf[a + h1] = csub(y0, u2);
      buf[a + h2] = cadd(y1, u3); buf[a + h1 + h2] = csub(y1, u3);
    }
    __syncthreads();
  }
}

DEV void mla_item(const Params& p, int li, int item, unsigned char* lds) {
  const int tid = opaque_tid(), lane = tid & 63, wave = tid >> 6;
  const int tok0 = item * 64 + wave * 16;
  __syncthreads();
  u16* Aq = (u16*)(lds + wave * 15360);
  u16* Akv = Aq + 16 * 264;
  float* KR = (float*)(Akv + 16 * 136);
  float* SSR = KR + 16 * 32;
  const u16* Pmh = (const u16*)(p.ws + OFF_PMH);
  const bool lat = tok0 < TLAT;
  const int b = lat ? (tok0 >> 12) : ((tok0 - TLAT) >> 8);
  const int kidx0 = lat ? (tok0 & 4095) : (4096 + ((tok0 - TLAT) & 255));
  {
    const int row = lane >> 2, sub = lane & 3;
    const u16* rp = Pmh + (size_t)(tok0 + row) * 1184;
    uint4 v[13];
#pragma unroll
    for (int i = 0; i < 13; ++i) v[i] = *(const uint4*)(rp + (sub + 4 * i) * 8);
    float ssq = 0.f, sskv = 0.f, ssr = 0.f;
    float f[8];
#pragma unroll
    for (int i = 0; i < 13; ++i) {
      unpack8(v[i], f);
      float s = 0.f;
#pragma unroll
      for (int j = 0; j < 8; ++j) s += f[j] * f[j];
      if (i < 8) ssq += s; else if (i < 12) sskv += s; else ssr += s;
    }
    ssq = sum4(ssq); sskv = sum4(sskv); ssr = sum4(ssr);
    const float rq = rsqrtf(ssq * (1.f / 256.f) + 1e-6f), rkv = rsqrtf(sskv * (1.f / 128.f) + 1e-6f);
    const float* qn = p.in[I_MQNORM] + li * 256;
    const float* kvn = p.in[I_MKVNORM] + li * 128;
#pragma unroll
    for (int i = 0; i < 13; ++i) {
      unpack8(v[i], f);
      if (i < 8) {
        const int col = (sub + 4 * i) * 8;
#pragma unroll
        for (int j = 0; j < 8; ++j) f[j] = f[j] * rq * qn[col + j];
        *(uint4*)(Aq + row * 264 + col) = pack8(f);
      } else if (i < 12) {
        const int col = (sub + 4 * i - 32) * 8;
#pragma unroll
        for (int j = 0; j < 8; ++j) f[j] = f[j] * rkv * kvn[col + j];
        *(uint4*)(Akv + row * 136 + col) = pack8(f);
      } else {
#pragma unroll
        for (int j = 0; j < 8; ++j) KR[row * 32 + sub * 8 + j] = f[j];
      }
    }
    if (sub == 0) SSR[row] = ssr;
  }
  __builtin_amdgcn_fence(__ATOMIC_RELEASE, "wavefront");
  __builtin_amdgcn_wave_barrier();
  __builtin_amdgcn_fence(__ATOMIC_ACQUIRE, "wavefront");
  const int c = lane & 15, quad = lane >> 4;
  const float* RC = (const float*)(p.ws + OFF_ROPE);
  const float* RS = RC + 65536;
  const float QSCALE = 0.10206207261596577f * 1.4426950408889634f;
  u16* QB = (u16*)(p.ws + OFF_QB);
  u16* KB = (u16*)(p.ws + OFF_KB);
  u16* VT = (u16*)(p.ws + OFF_VT);
  {
    const u16* W = (const u16*)(p.ws + OFF_WUQ) + (size_t)li * 576 * 256;
    const float* qg = p.in[I_MQGAIN] + li * 96;
#pragma unroll 1
    for (int h = 0; h < 6; ++h) {
      f32x4 acc[6];
#pragma unroll
      for (int j = 0; j < 6; ++j) acc[j] = (f32x4){0.f, 0.f, 0.f, 0.f};
#pragma unroll
      for (int ks = 0; ks < 8; ++ks) {
        const bf16x8 af = *(const bf16x8*)(Aq + c * 264 + ks * 32 + quad * 8);
#pragma unroll
        for (int j = 0; j < 6; ++j) {
          bf16x8 bb = *(const bf16x8*)(W + (size_t)(h * 96 + j * 16 + c) * 256 + ks * 32 + quad * 8);
          acc[j] = mfma16(af, bb, acc[j]);
        }
      }
#pragma unroll
      for (int r = 0; r < 4; ++r) {
        float s = 0.f;
#pragma unroll
        for (int j = 0; j < 6; ++j) s += acc[j][r] * acc[j][r];
        s = sum16(s);
        const float rs = rsqrtf(s * (1.f / 96.f) + 1e-6f) * QSCALE;
        const int rowi = quad * 4 + r;
        u16* dst = QB + ((size_t)(b * 6 + h) * KTOT + kidx0 + rowi) * 96;
#pragma unroll
        for (int j = 0; j < 4; ++j) dst[j * 16 + c] = f2bf(acc[j][r] * rs * qg[j * 16 + c]);
#pragma unroll
        for (int j = 4; j < 6; ++j) {
          float x = acc[j][r] * rs * qg[j * 16 + c];
          if (lat) {
            const float pr = __shfl_xor(x, 8);
            const int t = kidx0 + rowi;
            const float cs = RC[t * 16 + (j - 4) * 8 + (c & 7)], sn = RS[t * 16 + (j - 4) * 8 + (c & 7)];
            x = (c < 8) ? (x * cs - pr * sn) : (x * cs + pr * sn);
          }
          dst[j * 16 + c] = f2bf(x);
        }
      }
    }
  }
  {
    const u16* W = (const u16*)(p.ws + OFF_WUKV) + (size_t)li * 768 * 128;
    const float* kg = p.in[I_MKGAIN] + li * 96;
#pragma unroll 1
    for (int h = 0; h < 6; ++h) {
      f32x4 acc[8];
#pragma unroll
      for (int j = 0; j < 8; ++j) acc[j] = (f32x4){0.f, 0.f, 0.f, 0.f};
#pragma unroll
      for (int ks = 0; ks < 4; ++ks) {
        const bf16x8 af = *(const bf16x8*)(Akv + c * 136 + ks * 32 + quad * 8);
#pragma unroll
        for (int j = 0; j < 8; ++j) {
          bf16x8 bb = *(const bf16x8*)(W + (size_t)(h * 128 + j * 16 + c) * 128 + ks * 32 + quad * 8);
          acc[j] = mfma16(af, bb, acc[j]);
        }
      }
#pragma unroll
      for (int r = 0; r < 4; ++r) {
        const int rowi = quad * 4 + r;
        float s = 0.f;
#pragma unroll
        for (int j = 0; j < 4; ++j) s += acc[j][r] * acc[j][r];
        s = sum16(s);
        s += SSR[rowi];
        const float rk = rsqrtf(s * (1.f / 96.f) + 1e-6f);
        u16* dk = KB + ((size_t)(b * 6 + h) * KTOT + kidx0 + rowi) * 96;
#pragma unroll
        for (int j = 0; j < 4; ++j) dk[j * 16 + c] = f2bf(acc[j][r] * rk * kg[j * 16 + c]);
#pragma unroll
        for (int jj = 0; jj < 2; ++jj) {
          float x = KR[rowi * 32 + jj * 16 + c] * rk * kg[64 + jj * 16 + c];
          if (lat) {
            const float pr = KR[rowi * 32 + jj * 16 + (c ^ 8)] * rk * kg[64 + jj * 16 + (c ^ 8)];
            const int t = kidx0 + rowi;
            const float cs = RC[t * 16 + jj * 8 + (c & 7)], sn = RS[t * 16 + jj * 8 + (c & 7)];
            x = (c < 8) ? (x * cs - pr * sn) : (x * cs + pr * sn);
          }
          dk[64 + jj * 16 + c] = f2bf(x);
        }
#pragma unroll
        for (int j = 0; j < 4; ++j) VT[((size_t)(b * 6 + h) * 64 + j * 16 + c) * KTOT + kidx0 + rowi] = f2bf(acc[4 + j][r]);
      }
    }
  }
  __builtin_amdgcn_wave_barrier();
}

DEV void hy_item(const Params& p, int li, int part, int tt, unsigned char* lds) {
  const int tid = opaque_tid();
  u16* Z = (u16*)lds;
  int b, t0, L, tokbase; size_t obase;
  if (tt < 512) { b = tt >> 6; t0 = (tt & 63) * 64; L = 4096; tokbase = b * 4096; obase = (size_t)b * 256 * 4096; }
  else { int u = tt - 512; b = u >> 2; t0 = (u & 3) * 64; L = 256; tokbase = TLAT + b * 256; obase = (size_t)8 * 256 * 4096 + (size_t)b * 256 * 256; }
  const u16* Pmh = (const u16*)(p.ws + OFF_PMH);
  __syncthreads();
  for (int id = tid; id < 66 * 32; id += 256) {
    const int rr = id >> 5, ch = id & 31;
    const int t = t0 - 1 + rr;
    uint4 v = make_uint4(0, 0, 0, 0);
    if (t >= 0 && t < L) v = *(const uint4*)(Pmh + (size_t)(tokbase + t) * 1184 + 416 + part * 256 + ch * 8);
    *(uint4*)(Z + rr * 264 + ch * 8) = v;
  }
  __syncthreads();
  const int c = tid;
  const float* cw = p.in[I_HYCONV] + (size_t)li * 3 * 768 + part * 256 + c;
  const float w0 = cw[0], w1 = cw[768], w2 = cw[1536];
  u16* dst = (u16*)(p.ws + OFF_HYIN) + (size_t)part * TT * 256 + obase + (size_t)c * L + t0;
#pragma unroll
  for (int g = 0; g < 8; ++g) {
    float f[8];
#pragma unroll
    for (int j = 0; j < 8; ++j) {
      const int t = g * 8 + j;
      f[j] = w0 * bf2f(Z[t * 264 + c]) + w1 * bf2f(Z[(t + 1) * 264 + c]) + w2 * bf2f(Z[(t + 2) * 264 + c]);
    }
    *(uint4*)(dst + g * 8) = pack8(f);
  }
}

DEV void rwg_item(const Params& p, int li, int item, unsigned char* lds) {
  const int tid = opaque_tid(), lane = tid & 63, wave = tid >> 6;
  const int tok0 = item * 64 + wave * 16;
  __syncthreads();
  u16* Ag = (u16*)(lds + wave * 16384);
  u16* BV = Ag + 16 * 128;
  const u16* Prw = (const u16*)(p.ws + OFF_PRW);
  const float* cw = p.in[I_RWCONV] + (size_t)li * 3 * 1408;
#pragma unroll
  for (int i = 0; i < 4; ++i) {
    const int unit = lane + 64 * i, row = unit >> 4, c8 = unit & 15;
    const int tok = tok0 + row; bool hp, hn; tok_nb(tok, hp, hn);
    float f[8];
    conv8(Prw, 1408, tok, hp, hn, 1280 + c8 * 8, cw + 1280 + c8 * 8, 1408, f);
#pragma unroll
    for (int j = 0; j < 8; ++j) f[j] = sigmoidf_(f[j]);
    *(uint4*)(Ag + row * 128 + c8 * 8) = pack8(f);
  }
  const float* rk = p.in[I_RWRK] + li * 384;
  for (int it = 0; it < 12; ++it) {
    const int rh = it / 6, h = it % 6;
    const int row = rh * 8 + (lane >> 3), c8 = lane & 7;
    const int tok = tok0 + row; bool hp, hn; tok_nb(tok, hp, hn);
    const int col = h * 64 + c8 * 8;
    float r8[8], k8[8], v8[8];
    conv8(Prw, 1408, tok, hp, hn, col, cw + col, 1408, r8);
    conv8(Prw, 1408, tok, hp, hn, 384 + col, cw + 384 + col, 1408, k8);
    conv8(Prw, 1408, tok, hp, hn, 768 + col, cw + 768 + col, 1408, v8);
    float s = 0.f;
#pragma unroll
    for (int j = 0; j < 8; ++j) s += r8[j] * k8[j] * rk[col + j];
    s = sum8(s);
#pragma unroll
    for (int j = 0; j < 8; ++j) v8[j] *= s;
    *(uint4*)(BV + row * 384 + col) = pack8(v8);
  }
  __builtin_amdgcn_fence(__ATOMIC_RELEASE, "wavefront");
  __builtin_amdgcn_wave_barrier();
  __builtin_amdgcn_fence(__ATOMIC_ACQUIRE, "wavefront");
  const int c = lane & 15, quad = lane >> 4;
  bf16x8 af[4];
#pragma unroll
  for (int ks = 0; ks < 4; ++ks) af[ks] = *(const bf16x8*)(Ag + c * 128 + ks * 32 + quad * 8);
  const u16* W = (const u16*)(p.ws + OFF_GUT) + (size_t)li * 384 * 128;
  u16* G = (u16*)(p.ws + OFF_G);
  u16* BG = (u16*)(p.ws + OFF_BG);
  for (int h = 0; h < 6; ++h) {
    f32x4 acc[4];
#pragma unroll
    for (int j = 0; j < 4; ++j) acc[j] = (f32x4){0.f, 0.f, 0.f, 0.f};
#pragma unroll
    for (int ks = 0; ks < 4; ++ks)
#pragma unroll
      for (int j = 0; j < 4; ++j) {
        bf16x8 bb = *(const bf16x8*)(W + (size_t)(h * 64 + j * 16 + c) * 128 + ks * 32 + quad * 8);
        acc[j] = mfma16(af[ks], bb, acc[j]);
      }
#pragma unroll
    for (int j = 0; j < 4; ++j)
#pragma unroll
      for (int r = 0; r < 4; ++r) {
        const int rowi = quad * 4 + r, col = h * 64 + j * 16 + c;
        const float g = acc[j][r];
        G[(size_t)(tok0 + rowi) * 384 + col] = f2bf(g);
        BG[(size_t)(tok0 + rowi) * 384 + col] = f2bf(g * bf2f(BV[rowi * 384 + col]));
      }
  }
  __builtin_amdgcn_wave_barrier();
}

DEV void filt_item(const Params& p, int li, int sel, int o, int c, unsigned char* lds, const float2* TWs) {
  const int tid = opaque_tid();
  const int L = sel ? 256 : 4096, logn = sel ? 9 : 13, N2 = 2 * L;
  float2* buf = (float2*)lds;
  const int col0 = o * 512 + c, col1 = col0 + 256;
  __syncthreads();
  const float* w3a = p.in[I_HYW3] + (size_t)li * 64 * 1024 + col0;
  const float* w3b = w3a + 256;
  const float b30 = p.in[I_HYB3][li * 1024 + col0], b31 = p.in[I_HYB3][li * 1024 + col1];
  const float rate = 3.0701134573253946f + (15.350567286626972f - 3.0701134573253946f) * (float)c * (1.f / 255.f);
  const float* H2 = (const float*)(p.ws + OFF_H2) + ((size_t)li * 4352 + (sel ? 4096 : 0)) * 64;
  float ss = 0.f;
#pragma unroll 1
  for (int dd = 0; dd < 2; ++dd) {
    const float* w3 = dd ? w3b : w3a;
    const float b3v = dd ? b31 : b30;
    for (int t = tid; t < L; t += 256) {
      const float4* hr = (const float4*)(H2 + (size_t)t * 64);
      float d0 = b3v;
#pragma unroll
      for (int i = 0; i < 16; ++i) {
        float4 h = hr[i];
        d0 += h.x * w3[(i * 4) * 1024] + h.y * w3[(i * 4 + 1) * 1024] + h.z * w3[(i * 4 + 2) * 1024] + h.w * w3[(i * 4 + 3) * 1024];
      }
      const float v0 = d0 * __expf(-((float)t / (float)L) * rate);
      if (dd == 0) { buf[t] = make_float2(v0, 0.f); ss += v0 * v0; }
      else if (t >= 1) { buf[N2 - t] = make_float2(v0, 0.f); ss += v0 * v0; }
    }
  }
  ss = wave_sum(ss);
  float tot = 0.f;
  if ((tid & 63) == 0 && tid < 128) ((float*)&buf[L])[tid >> 6] = ss;
  __syncthreads();
  tot += buf[L].x + buf[L].y;
  __syncthreads();
  if ((tid & 63) == 0 && tid >= 128) ((float*)&buf[L])[(tid >> 6) - 2] = ss;
  __syncthreads();
  tot += buf[L].x + buf[L].y;
  __syncthreads();
  if (tid == 0) buf[L] = make_float2(0.f, 0.f);
  __syncthreads();
  const float scale = rsqrtf(tot) / (float)N2;
  fft_fwd(buf, logn, TWs);
  float2* HF = (float2*)(p.ws + OFF_HF) + (sel ? (size_t)2 * 256 * 8192 : 0) + (size_t)(o * 256 + c) * N2;
  for (int i = tid; i < N2; i += 256) { float2 v = buf[i]; HF[i] = make_float2(v.x * scale, v.y * scale); }
}

DEV void phaseA(const Params& p, int li, unsigned char* lds) {
  const u16* XN = (const u16*)(p.ws + OFF_XN);
  const u16* Wt = (const u16*)(p.ws + OFF_WIN) + (size_t)li * 2688 * 1024;
  u16* Prw = (u16*)(p.ws + OFF_PRW);
  u16* Pmh = (u16*)(p.ws + OFF_PMH);
  const int n_filt = (li == 0) ? 1024 : 512;
  const float2* TWs = stage_tw(p, lds);
  const int vbid = ((gridDim.x & 7) == 0) ? (int)((blockIdx.x & 7) * (gridDim.x >> 3) + (blockIdx.x >> 3)) : (int)blockIdx.x;
  for (int item0 = vbid; item0 < 136 * 21 + n_filt; item0 += gridDim.x) {
    if (item0 < n_filt) { const int sel = item0 >> 9, r = item0 & 511; filt_item(p, li, sel, r >> 8, r & 255, lds, TWs); continue; }
    const int item = item0 - n_filt;
    const int m0 = (item / 21) * 256, n0 = (item % 21) * 128;
    gemm_tile<256, 128, 2, 2>(lds, 1024,
      [&](int row, int k) { return *(const uint4*)(XN + (size_t)(m0 + row) * 1024 + k); },
      [&](int row, int k) { return *(const uint4*)(Wt + (size_t)(n0 + row) * 1024 + k); },
      [&](int mrow, int ncol, f32x4 a) {
        const int n = n0 + ncol;
        if (n < 2592) {
#pragma unroll
          for (int r = 0; r < 4; ++r) {
            const int tok = m0 + mrow + r;
            if (n < 1408) Prw[(size_t)tok * 1408 + n] = f2bf(a[r]);
            else Pmh[(size_t)tok * 1184 + (n - 1408)] = f2bf(a[r]);
          }
        }
      });
  }
}


DEV void phaseB(const Params& p, int li, unsigned char* lds) {
  const bool need_ctx = (li == 0);
  const int n_mla = 544;
  const int n_hytt = need_ctx ? 544 : 512, n_hy = n_hytt * 3;
  const int n_rwg = need_ctx ? 544 : 512;
  const int total = n_mla + n_hy + n_rwg;
  for (int item = blockIdx.x; item < total; item += gridDim.x) {
    int r = item;
    if (r < n_mla) { mla_item(p, li, r, lds); continue; } r -= n_mla;
    if (r < n_hy) { hy_item(p, li, r / n_hytt, r % n_hytt, lds); continue; } r -= n_hy;
    rwg_item(p, li, r, lds);
  }
}

DEV void scan_item(const Params& p, int li, int item, unsigned char* lds) {
  const int tid = opaque_tid(), lane = tid & 63, wave = tid >> 6;
  const int dir = item & 1, bh = item >> 1, b = bh / 6, h = bh % 6;
  float* STEP = (float*)lds;
  u16* DL = (u16*)(lds + 49152);
  u16* AL = DL + 32 * 72;
  u16* YS = (u16*)(lds + 49152 + 2 * 32 * 72 * 2);
  const u16* Prw = (const u16*)(p.ws + OFF_PRW);
  const float* cw = p.in[I_RWCONV] + (size_t)li * 3 * 1408;
  const float* kkw = p.in[I_RWKK] + li * 384 + h * 64;
  const float* kaw = p.in[I_RWKA] + li * 384 + h * 64;
  const float* d0 = p.in[I_RWD0] + (size_t)(li * 2 + dir) * 384 + h * 64;
  const float* a0 = p.in[I_RWA0] + (size_t)(li * 2 + dir) * 384 + h * 64;
  const u16* DUT = (const u16*)(p.ws + OFF_DUT) + ((size_t)(li * 2 + dir) * 384 + h * 64) * 64;
  const u16* AUT = (const u16*)(p.ws + OFF_AUT) + ((size_t)(li * 2 + dir) * 384 + h * 64) * 64;
  u16* Yd = (u16*)(p.ws + (dir ? OFF_Y1 : OFF_Y0));
  const int vrow = tid >> 2, q = tid & 3;
  f32x2 S[8];
#pragma unroll
  for (int i = 0; i < 8; ++i) S[i] = (f32x2){0.f, 0.f};
  const int c = lane & 15, quad = lane >> 4;
  __syncthreads();
  for (int ch = 0; ch < 136; ++ch) {
    int tokbase, t0, L;
    if (ch < 8) { L = 256; tokbase = TLAT + b * 256; t0 = (dir ? (7 - ch) : ch) * 32; }
    else { L = 4096; tokbase = b * 4096; const int cc = ch - 8; t0 = (dir ? (127 - cc) : cc) * 32; }
#pragma unroll
    for (int i = 0; i < 5; ++i) {
      const int id = tid + 256 * i;
      const int c8 = id & 7, part = (id >> 3) % 5, tl = id / 40;
      const int t = t0 + tl, tok = tokbase + t;
      const int col = (part < 3) ? (part * 384 + h * 64 + c8 * 8) : (1152 + (part - 3) * 64 + c8 * 8);
      float f[8];
      conv8(Prw, 1408, tok, t > 0, t < L - 1, col, cw + col, 1408, f);
      float ssk = 0.f;
      float kr[8];
#pragma unroll
      for (int j = 0; j < 8; ++j) { kr[j] = f[j] * kkw[c8 * 8 + j]; ssk += kr[j] * kr[j]; }
      ssk = sum8(ssk);
      float* sp = STEP + tl * 384;
      if (part == 0) { *(float4*)(sp + 256 + c8 * 8) = make_float4(f[0], f[1], f[2], f[3]); *(float4*)(sp + 256 + c8 * 8 + 4) = make_float4(f[4], f[5], f[6], f[7]); }
      else if (part == 1) {
        *(float4*)(sp + 192 + c8 * 8) = make_float4(f[0], f[1], f[2], f[3]); *(float4*)(sp + 192 + c8 * 8 + 4) = make_float4(f[4], f[5], f[6], f[7]);
        const float rs = rsqrtf(ssk + 1e-12f);
        *(float4*)(sp + c8 * 8) = make_float4(kr[0] * rs, kr[1] * rs, kr[2] * rs, kr[3] * rs);
        *(float4*)(sp + c8 * 8 + 4) = make_float4(kr[4] * rs, kr[5] * rs, kr[6] * rs, kr[7] * rs);
      }
      else if (part == 2) { *(float4*)(sp + 320 + c8 * 8) = make_float4(f[0], f[1], f[2], f[3]); *(float4*)(sp + 320 + c8 * 8 + 4) = make_float4(f[4], f[5], f[6], f[7]); }
      else if (part == 3) {
#pragma unroll
        for (int j = 0; j < 8; ++j) f[j] = tanhf(f[j]);
        *(uint4*)(DL + tl * 72 + c8 * 8) = pack8(f);
      }
      else { *(uint4*)(AL + tl * 72 + c8 * 8) = pack8(f); }
    }
    __syncthreads();
    {
      const int mt = wave >> 1;
      bf16x8 ad[2], aa[2];
#pragma unroll
      for (int ks = 0; ks < 2; ++ks) {
        ad[ks] = *(const bf16x8*)(DL + (mt * 16 + c) * 72 + ks * 32 + quad * 8);
        aa[ks] = *(const bf16x8*)(AL + (mt * 16 + c) * 72 + ks * 32 + quad * 8);
      }
#pragma unroll
      for (int jn = 0; jn < 2; ++jn) {
        const int nt = (wave & 1) * 2 + jn;
        f32x4 accd = (f32x4){0.f, 0.f, 0.f, 0.f}, acca = accd;
#pragma unroll
        for (int ks = 0; ks < 2; ++ks) {
          bf16x8 bd = *(const bf16x8*)(DUT + (size_t)(nt * 16 + c) * 64 + ks * 32 + quad * 8);
          bf16x8 ba = *(const bf16x8*)(AUT + (size_t)(nt * 16 + c) * 64 + ks * 32 + quad * 8);
          accd = mfma16(ad[ks], bd, accd);
          acca = mfma16(aa[ks], ba, acca);
        }
        const int col = nt * 16 + c;
        const float d0c = d0[col], a0c = a0[col], kac = kaw[col];
#pragma unroll
        for (int r = 0; r < 4; ++r) {
          const int tl = mt * 16 + quad * 4 + r;
          float* sp = STEP + tl * 384;
          const float w = __expf(-0.6065306597f * sigmoidf_(d0c + accd[r]));
          const float a = sigmoidf_(a0c + acca[r]);
          const float kraw = sp[192 + col], kk = sp[col];
          sp[64 + col] = w;
          sp[128 + col] = a * kk;
          sp[192 + col] = kraw * (1.f + (a - 1.f) * kac);
        }
      }
    }
    __syncthreads();
#define SCAN_LOAD(TL, KK, W, AK, KR, RR, VV) { \
      const float* sp_ = STEP + (TL) * 384 + q * 16; \
      _Pragma("unroll") for (int i = 0; i < 4; ++i) { f32x4 t_; \
        t_ = *(const f32x4*)(sp_ + i * 4);        KK[2 * i] = t_.xy; KK[2 * i + 1] = t_.zw; \
        t_ = *(const f32x4*)(sp_ + 64 + i * 4);   W[2 * i] = t_.xy;  W[2 * i + 1] = t_.zw; \
        t_ = *(const f32x4*)(sp_ + 128 + i * 4);  AK[2 * i] = t_.xy; AK[2 * i + 1] = t_.zw; \
        t_ = *(const f32x4*)(sp_ + 192 + i * 4);  KR[2 * i] = t_.xy; KR[2 * i + 1] = t_.zw; \
        t_ = *(const f32x4*)(sp_ + 256 + i * 4);  RR[2 * i] = t_.xy; RR[2 * i + 1] = t_.zw; } \
      VV = STEP[(TL) * 384 + 320 + vrow]; }
#define SCAN_STEP(TL, KK, W, AK, KR, RR, VV) { \
      f32x2 pa = S[0] * KK[0], pb = S[1] * KK[1]; \
      _Pragma("unroll") for (int i = 2; i < 8; i += 2) { pa += S[i] * KK[i]; pb += S[i + 1] * KK[i + 1]; } \
      pa += pb; \
      float pd = sum4(pa.x + pa.y); \
      const f32x2 npd = (f32x2){-pd, -pd}, vv2 = (f32x2){VV, VV}; \
      f32x2 ya = (f32x2){0.f, 0.f}, yb = ya; \
      _Pragma("unroll") for (int i = 0; i < 8; i += 2) { \
        S[i] = S[i] * W[i] + (vv2 * KR[i] + npd * AK[i]); \
        S[i + 1] = S[i + 1] * W[i + 1] + (vv2 * KR[i + 1] + npd * AK[i + 1]); \
        ya += S[i] * RR[i]; yb += S[i + 1] * RR[i + 1]; } \
      ya += yb; \
      const float y = sum4(ya.x + ya.y); \
      if (q == 0) YS[(TL) * 64 + vrow] = f2bf(y); }
    for (int st = 0; st < 32; st += 2) {
      const int tl0 = dir ? (31 - st) : st, tl1 = dir ? (30 - st) : (st + 1);
      f32x2 kk0[8], w0[8], ak0[8], kr0[8], rr0[8], kk1[8], w1[8], ak1[8], kr1[8], rr1[8];
      float vv0, vv1;
      SCAN_LOAD(tl0, kk0, w0, ak0, kr0, rr0, vv0)
      SCAN_LOAD(tl1, kk1, w1, ak1, kr1, rr1, vv1)
      SCAN_STEP(tl0, kk0, w0, ak0, kr0, rr0, vv0)
      SCAN_STEP(tl1, kk1, w1, ak1, kr1, rr1, vv1)
    }
    __syncthreads();
    {
      const int tl = tid >> 3, c8 = tid & 7;
      *(uint4*)(Yd + (size_t)(tokbase + t0 + tl) * 384 + h * 64 + c8 * 8) = *(const uint4*)(YS + tl * 64 + c8 * 8);
    }
  }
}

DEV void attn_item(const Params& p, int b, int h, int q0, int kt0, int kt1, int tok_q0, unsigned char* lds) {
  const int tid = opaque_tid(), lane = tid & 63, wave = tid >> 6;
  const int c = lane & 15, quad = lane >> 4;
  u16* Ks = (u16*)lds;
  u16* Vs = Ks + 64 * 104;
  const size_t bh = (size_t)(b * 6 + h);
  const u16* QB = (const u16*)(p.ws + OFF_QB) + bh * KTOT * 96;
  const u16* KB = (const u16*)(p.ws + OFF_KB) + bh * KTOT * 96;
  const u16* VT = (const u16*)(p.ws + OFF_VT) + bh * 64 * KTOT;
  bf16x8 qf[4][3];
#pragma unroll
  for (int n = 0; n < 4; ++n)
#pragma unroll
    for (int ks = 0; ks < 3; ++ks) qf[n][ks] = *(const bf16x8*)(QB + (size_t)(q0 + wave * 64 + n * 16 + c) * 96 + ks * 32 + quad * 8);
  f32x4 ot[4][4];
#pragma unroll
  for (int d = 0; d < 4; ++d)
#pragma unroll
    for (int n = 0; n < 4; ++n) ot[d][n] = (f32x4){0.f, 0.f, 0.f, 0.f};
  float mrun[4] = {-1e30f, -1e30f, -1e30f, -1e30f}, lsum[4] = {0.f, 0.f, 0.f, 0.f};
  uint4 rk0, rk1, rk2, rv0, rv1;
#define ATT_KLD(KT, I) (*(const uint4*)(KB + (size_t)((KT) * 64 + (tid + 256 * (I)) / 12) * 96 + ((tid + 256 * (I)) % 12) * 8))
#define ATT_VLD(KT, I) (*(const uint4*)(VT + (size_t)((tid + 256 * (I)) >> 3) * KTOT + (KT) * 64 + ((tid + 256 * (I)) & 7) * 8))
#define ATT_GLOAD(KT) { rk0 = ATT_KLD(KT, 0); rk1 = ATT_KLD(KT, 1); rk2 = ATT_KLD(KT, 2); rv0 = ATT_VLD(KT, 0); rv1 = ATT_VLD(KT, 1); }
  ATT_GLOAD(kt0);
  for (int kt = kt0; kt < kt1; ++kt) {
    __syncthreads();
    { const int id = tid; *(uint4*)(Ks + (id / 12) * 104 + (id % 12) * 8) = rk0; }
    { const int id = tid + 256; *(uint4*)(Ks + (id / 12) * 104 + (id % 12) * 8) = rk1; }
    { const int id = tid + 512; *(uint4*)(Ks + (id / 12) * 104 + (id % 12) * 8) = rk2; }
    { const int id = tid; uint2* d = (uint2*)(Vs + (id >> 3) * 68 + (id & 7) * 8); d[0] = make_uint2(rv0.x, rv0.y); d[1] = make_uint2(rv0.z, rv0.w); }
    { const int id = tid + 256; uint2* d = (uint2*)(Vs + (id >> 3) * 68 + (id & 7) * 8); d[0] = make_uint2(rv1.x, rv1.y); d[1] = make_uint2(rv1.z, rv1.w); }
    __syncthreads();
    if (kt + 1 < kt1) ATT_GLOAD(kt + 1);
    f32x4 st[4][4];
#pragma unroll
    for (int i = 0; i < 4; ++i)
#pragma unroll
      for (int n = 0; n < 4; ++n) st[i][n] = (f32x4){0.f, 0.f, 0.f, 0.f};
#pragma unroll
    for (int ks = 0; ks < 3; ++ks)
#pragma unroll
      for (int i = 0; i < 4; ++i) {
        const bf16x8 ak = *(const bf16x8*)(Ks + (i * 16 + c) * 104 + ks * 32 + quad * 8);
#pragma unroll
        for (int n = 0; n < 4; ++n) st[i][n] = mfma16(ak, qf[n][ks], st[i][n]);
      }
    bf16x8 pb[4][2];
#pragma unroll
    for (int n = 0; n < 4; ++n) {
      float mx = st[0][n][0];
#pragma unroll
      for (int i = 0; i < 4; ++i)
#pragma unroll
        for (int r = 0; r < 4; ++r) mx = fmaxf(mx, st[i][n][r]);
      mx = fmaxf(mx, __shfl_xor(mx, 16)); mx = fmaxf(mx, __shfl_xor(mx, 32));
      const float mnew = fmaxf(mrun[n], mx);
      const float alpha = __builtin_amdgcn_exp2f(mrun[n] - mnew);
      mrun[n] = mnew;
      float ls = 0.f;
      float pv[16];
#pragma unroll
      for (int i = 0; i < 4; ++i)
#pragma unroll
        for (int r = 0; r < 4; ++r) { const float e = __builtin_amdgcn_exp2f(st[i][n][r] - mnew); pv[i * 4 + r] = e; ls += e; }
      lsum[n] = lsum[n] * alpha + ls;
      if (__builtin_amdgcn_ballot_w64(alpha != 1.0f) != 0ull) {
#pragma unroll
        for (int d = 0; d < 4; ++d) ot[d][n] *= alpha;
      }
#pragma unroll
      for (int kk = 0; kk < 2; ++kk) pb[n][kk] = as_bf8(pack8(pv + kk * 8));
    }
#pragma unroll
    for (int kk = 0; kk < 2; ++kk)
#pragma unroll
      for (int d = 0; d < 4; ++d) {
        const uint2 lo = *(const uint2*)(Vs + (d * 16 + c) * 68 + kk * 32 + quad * 4);
        const uint2 hi = *(const uint2*)(Vs + (d * 16 + c) * 68 + kk * 32 + 16 + quad * 4);
        const bf16x8 av = as_bf8(make_uint4(lo.x, lo.y, hi.x, hi.y));
#pragma unroll
        for (int n = 0; n < 4; ++n) ot[d][n] = mfma16(av, pb[n][kk], ot[d][n]);
      }
  }
  u16* ATT = (u16*)(p.ws + OFF_ATT);
#pragma unroll
  for (int n = 0; n < 4; ++n) {
    float l = lsum[n];
    l += __shfl_xor(l, 16); l += __shfl_xor(l, 32);
    const float inv = 1.f / l;
    const int tok = tok_q0 + wave * 64 + n * 16 + c;
#pragma unroll
    for (int d = 0; d < 4; ++d) {
      uint2 o;
      o.x = pack2(ot[d][n][0] * inv, ot[d][n][1] * inv);
      o.y = pack2(ot[d][n][2] * inv, ot[d][n][3] * inv);
      *(uint2*)(ATT + (size_t)tok * 384 + h * 64 + d * 16 + quad * 4) = o;
    }
  }
}

template <int NJ>
DEV void hyfft_item(const Params& p, int li, int c, int bp, unsigned char* lds, const float2* TW) {
  constexpr int L = NJ * 256, N2 = 2 * L, logn = (NJ == 16) ? 13 : 9;
  const int tid = opaque_tid();
  float2* buf = (float2*)lds;
  const size_t seqoff = (NJ == 16) ? 0 : (size_t)8 * 256 * 4096;
  const size_t o0 = seqoff + ((size_t)(2 * bp) * 256 + c) * L, o1 = seqoff + ((size_t)(2 * bp + 1) * 256 + c) * L;
  const u16* HG0 = (const u16*)(p.ws + OFF_HYIN);
  const u16* HG1 = HG0 + (size_t)TT * 256;
  const u16* HU = HG1 + (size_t)TT * 256;
  u16* HO = (u16*)(p.ws + OFF_HYO);
  const float2* HF = (const float2*)(p.ws + OFF_HF) + ((NJ == 16) ? 0 : (size_t)2 * 256 * 8192);
  float2 yr[NJ];
  __syncthreads();
#pragma unroll
  for (int j = 0; j < NJ; ++j) {
    const int t = tid + 256 * j;
    yr[j] = make_float2(bf2f(HU[o0 + t]), bf2f(HU[o1 + t]));
    buf[t] = yr[j];
    buf[L + t] = make_float2(0.f, 0.f);
  }
  __syncthreads();
#pragma unroll 1
  for (int o = 0; o < 2; ++o) {
    fft_fwd(buf, logn, TW);
    const float2* hf = HF + (size_t)(o * 256 + c) * N2;
    for (int i = tid; i < N2; i += 256) buf[i] = cmul(buf[i], hf[i]);
    __syncthreads();
    fft_inv(buf, logn, TW);
    const float bias = p.in[I_HYBIAS][(li * 2 + o) * 256 + c];
    const u16* HG = o ? HG1 : HG0;
#pragma unroll
    for (int j = 0; j < NJ; ++j) {
      const int t = tid + 256 * j;
      const float2 v = buf[t];
      yr[j].x = bf2f(HG[o0 + t]) * (v.x + yr[j].x * bias);
      yr[j].y = bf2f(HG[o1 + t]) * (v.y + yr[j].y * bias);
    }
    __syncthreads();
    if (o == 0) {
#pragma unroll
      for (int j = 0; j < NJ; ++j) { const int t = tid + 256 * j; buf[t] = yr[j]; buf[L + t] = make_float2(0.f, 0.f); }
      __syncthreads();
    } else {
#pragma unroll
      for (int j = 0; j < NJ; ++j) { const int t = tid + 256 * j; HO[o0 + t] = f2bf(yr[j].x); HO[o1 + t] = f2bf(yr[j].y); }
    }
  }
}

DEV void phaseC(const Params& p, int li, unsigned char* lds, int cidx = -1, int only = 0) {
  const bool need_ctx = (li == 0);
  const int n_scan = (only == 0 || only == 1) ? 96 : 0, n_attn = (only == 0 || only == 2) ? 768 : 0, n_fft = (only == 0 || only == 3) ? 1024 : 0, n_attc = (need_ctx && only == 0) ? 48 : 0, n_fftc = (need_ctx && only == 0) ? 1024 : 0;
  const int total = n_scan + n_attn + n_fft + n_attc + n_fftc;
  const float2* TWs = stage_tw(p, lds);
  unsigned* ctr = (unsigned*)(p.ws + OFF_CTR) + (cidx < 0 ? li : cidx);
  int* sitem = (int*)(lds + LDS_BYTES - 16);
  for (;;) {
    __syncthreads();
    if (threadIdx.x == 0) *sitem = (int)atomicAdd(ctr, 1u);
    __syncthreads();
    int r = *sitem;
    if (r >= total) break;
    if (r < n_scan) { scan_item(p, li, r, lds); continue; } r -= n_scan;
    if (r < n_attn) { const int bh = r >> 4, qt = r & 15; const int b = bh / 6, h = bh % 6; attn_item(p, b, h, qt * 256, 0, 68, b * 4096 + qt * 256, lds); continue; } r -= n_attn;
    if (r < n_fft) { hyfft_item<16>(p, li, r >> 2, r & 3, lds, TWs); continue; } r -= n_fft;
    if (r < n_attc) { const int bh = r; const int b = bh / 6, h = bh % 6; attn_item(p, b, h, 4096, 64, 68, TLAT + b * 256, lds); continue; } r -= n_attc;
    hyfft_item<1>(p, li, r >> 2, r & 3, lds, TWs);
  }
}

constexpr size_t OFF_MIX = OFF_QB;
DEV void phaseD0(const Params& p, int li) {
  const int tid = opaque_tid();
  const int ntok = (li == 0) ? TT : TLAT;
  const u16* Y0 = (const u16*)(p.ws + OFF_Y0);
  const u16* Y1 = (const u16*)(p.ws + OFF_Y1);
  const u16* G = (const u16*)(p.ws + OFF_G);
  const u16* BG = (const u16*)(p.ws + OFF_BG);
  const u16* ATT = (const u16*)(p.ws + OFF_ATT);
  const u16* HO = (const u16*)(p.ws + OFF_HYO);
  u16* MIX = (u16*)(p.ws + OFF_MIX);
  const float* gng = p.in[I_RWGNG] + li * 384;
  const float* gnb = p.in[I_RWGNB] + li * 384;
  for (int item = blockIdx.x; item < ntok / 32; item += gridDim.x) {
    const int tok = item * 32 + (tid >> 3), c8 = tid & 7;
#pragma unroll 2
    for (int kg = 0; kg < 16; ++kg) {
      const int k = kg * 64 + c8 * 8;
      uint4 o;
      if (kg < 6) {
        float a[8], bb[8], y[8];
        unpack8(*(const uint4*)(Y0 + (size_t)tok * 384 + k), a);
        unpack8(*(const uint4*)(Y1 + (size_t)tok * 384 + k), bb);
        float sm = 0.f;
#pragma unroll
        for (int j = 0; j < 8; ++j) { y[j] = a[j] + bb[j]; sm += y[j]; }
        sm = sum8(sm);
        const float mu = sm * (1.f / 64.f);
        float v = 0.f;
#pragma unroll
        for (int j = 0; j < 8; ++j) { y[j] -= mu; v += y[j] * y[j]; }
        v = sum8(v);
        const float rstd = rsqrtf(v * (1.f / 64.f) + 64e-5f);
        float g[8], bg[8];
        unpack8(*(const uint4*)(G + (size_t)tok * 384 + k), g);
        unpack8(*(const uint4*)(BG + (size_t)tok * 384 + k), bg);
#pragma unroll
        for (int j = 0; j < 8; ++j) y[j] = (y[j] * rstd * gng[k + j] + gnb[k + j]) * g[j] + bg[j];
        o = pack8(y);
      } else if (kg < 12) {
        o = *(const uint4*)(ATT + (size_t)tok * 384 + (k - 384));
      } else {
        const int ch = k - 768;
        const u16* src; int L;
        if (tok < TLAT) { L = 4096; src = HO + ((size_t)(tok >> 12) * 256 + ch) * 4096 + (tok & 4095); }
        else { L = 256; const int u = tok - TLAT; src = HO + (size_t)8 * 256 * 4096 + ((size_t)(u >> 8) * 256 + ch) * 256 + (u & 255); }
        o.x = (unsigned)src[0] | ((unsigned)src[(size_t)L] << 16);
        o.y = (unsigned)src[(size_t)2 * L] | ((unsigned)src[(size_t)3 * L] << 16);
        o.z = (unsigned)src[(size_t)4 * L] | ((unsigned)src[(size_t)5 * L] << 16);
        o.w = (unsigned)src[(size_t)6 * L] | ((unsigned)src[(size_t)7 * L] << 16);
      }
      *(uint4*)(MIX + (size_t)tok * 1024 + k) = o;
    }
  }
}
DEV void phaseD1(const Params& p, int li, unsigned char* lds) {
  const bool orig = (li == 0);
  const int nmt = (li == 0) ? 272 : 256;
  const u16* Wt = (const u16*)(p.ws + OFF_WOUT) + (size_t)li * 1024 * 1024;
  const u16* MIX = (const u16*)(p.ws + OFF_MIX);
  for (int item = blockIdx.x; item < nmt * 8; item += gridDim.x) {
    const int m0 = (item >> 3) * 128, n0 = (item & 7) * 128;
    gemm_tile<128, 128, 2, 2>(lds, 1024,
      [&](int row, int k) { return *(const uint4*)(MIX + (size_t)(m0 + row) * 1024 + k); },
      [&](int row, int k) { return *(const uint4*)(Wt + (size_t)(n0 + row) * 1024 + k); },
      [&](int mrow, int ncol, f32x4 a) {
        const int n = n0 + ncol;
#pragma unroll
        for (int r = 0; r < 4; ++r) {
          const int tok = m0 + mrow + r;
          const float gm = modp(p, li, tok_mv(tok), 2)[n];
          xdst(p, tok)[n] = xsrc(p, tok, orig)[n] + gm * a[r];
        }
      });
  }
}

constexpr size_t OFF_PUB = OFF_PRW;
typedef float f32x2v __attribute__((ext_vector_type(2)));
DEV unsigned pack_fp8x4(float a, float b, float c, float d) {
  int p = __builtin_amdgcn_cvt_pk_fp8_f32(a, b, 0, false);
  p = __builtin_amdgcn_cvt_pk_fp8_f32(c, d, p, true);
  return (unsigned)p;
}
DEV void unpack_fp8x4(unsigned v, float* f) {
  const f32x2v lo = __builtin_amdgcn_cvt_pk_f32_fp8((int)v, false), hi = __builtin_amdgcn_cvt_pk_f32_fp8((int)v, true);
  f[0] = lo.x; f[1] = lo.y; f[2] = hi.x; f[3] = hi.y;
}
constexpr float PEER_USCALE = 64.f, PEER_VSCALE = 4.f;
DEV void cvt_peer(const Params& p, int li) {
  const int tid = opaque_tid();
  const float* PU = p.in[I_PU] + (size_t)li * 16384 * 1024;
  const float* PV = p.in[I_PV] + (size_t)li * 16384 * 1024;
  unsigned char* dst = p.ws + OFF_PUB;
#pragma unroll 4
  for (int item = blockIdx.x; item < 16384; item += gridDim.x) {
    const bool isu = item < 8192;
    const float* src = isu ? PU + (size_t)item * 2048 : PV + (size_t)(item - 8192) * 2048;
    const float sc = isu ? PEER_USCALE : PEER_VSCALE;
    const f32x4 a = __builtin_nontemporal_load((const f32x4*)(src + tid * 8)), b = __builtin_nontemporal_load((const f32x4*)(src + tid * 8 + 4));
    uint2 o;
    o.x = pack_fp8x4(a.x * sc, a.y * sc, a.z * sc, a.w * sc);
    o.y = pack_fp8x4(b.x * sc, b.y * sc, b.z * sc, b.w * sc);
    *(uint2*)(dst + (size_t)item * 2048 + tid * 8) = o;
  }
}

DEV unsigned fkey(float x) { const unsigned u = __float_as_uint(x); return (u & 0x80000000u) ? ~u : (u | 0x80000000u); }
DEV float funkey(unsigned k) { return __uint_as_float((k & 0x80000000u) ? (k ^ 0x80000000u) : ~k); }
DEV unsigned umax16(unsigned m) {
  m = max(m, (unsigned)dppi<0x128>((int)m)); m = max(m, (unsigned)dppi<0x124>((int)m));
  m = max(m, (unsigned)dppi<0x122>((int)m)); m = max(m, (unsigned)dppi<0x121>((int)m));
  return m;
}
DEV bool better(float v, int i, float ov, int oi) { return v > ov || (v == ov && i < oi); }
#define ARGMAX16_STEP(V, I, CTRL) { const float ov_ = dppf<CTRL>(V); const int oi_ = dppi<CTRL>(I); if (better(ov_, oi_, V, I)) { V = ov_; I = oi_; } }
#define ARGMAX16(V, I) ARGMAX16_STEP(V, I, 0x128) ARGMAX16_STEP(V, I, 0x124) ARGMAX16_STEP(V, I, 0x122) ARGMAX16_STEP(V, I, 0x121)
DEV void phaseD3(const Params& p, int li, unsigned char* lds) {
  const int nmt = (li == 0) ? 272 : 256;
  const u16* XN = (const u16*)(p.ws + OFF_XN);
  const int tid = opaque_tid(), lane = tid & 63, wave = tid >> 6;
  const int c = lane & 15, quad = lane >> 4, base = lane & 48;
  u16* Qs = (u16*)lds;
  u16* KS = (u16*)(lds + 67584);
  const float NEG = -3.0e38f;
  for (int item = blockIdx.x; item < nmt * 8; item += gridDim.x) {
    const int m0 = (item >> 3) * 128, h = item & 7;
    const u16* Wt = (const u16*)(p.ws + OFF_WQ) + ((size_t)li * 2048 + h * 256) * 1024;
    gemm_tile<128, 256, 1, 4>(lds, 1024,
      [&](int row, int k) { return *(const uint4*)(XN + (size_t)(m0 + row) * 1024 + k); },
      [&](int row, int k) { return *(const uint4*)(Wt + (size_t)row * 1024 + k); },
      [&](int mrow, int ncol, f32x4 a) {
#pragma unroll
        for (int r = 0; r < 4; ++r) Qs[(mrow + r) * 264 + ncol] = f2bf(a[r]);
      });
#pragma unroll 1
    for (int mt = 0; mt < 2; ++mt) {
    float sv[2][4]; int si[2][4];
#pragma unroll
    for (int pp = 0; pp < 2; ++pp) {
      const u16* keys = (const u16*)(p.ws + OFF_KEYS) + ((size_t)((li * 8 + h) * 2 + pp) * 128) * 128;
      f32x4 s[8];
#pragma unroll
      for (int j = 0; j < 8; ++j) s[j] = (f32x4){0.f, 0.f, 0.f, 0.f};
#pragma unroll
      for (int hf = 0; hf < 2; ++hf) {
        __syncthreads();
#pragma unroll
        for (int i = 0; i < 4; ++i) { const int id = tid + 256 * i; *(uint4*)(KS + (id >> 4) * 136 + (id & 15) * 8) = *(const uint4*)(keys + (size_t)(hf * 64 + (id >> 4)) * 128 + (id & 15) * 8); }
        __syncthreads();
#pragma unroll
        for (int ks = 0; ks < 4; ++ks) {
          const bf16x8 af = *(const bf16x8*)(Qs + (wave * 32 + mt * 16 + c) * 264 + pp * 128 + ks * 32 + quad * 8);
#pragma unroll
          for (int j = 0; j < 4; ++j) s[hf * 4 + j] = mfma16(af, *(const bf16x8*)(KS + (j * 16 + c) * 136 + ks * 32 + quad * 8), s[hf * 4 + j]);
        }
      }
      unsigned key[8][4];
#pragma unroll
      for (int j = 0; j < 8; ++j)
#pragma unroll
        for (int r = 0; r < 4; ++r) key[j][r] = (fkey(s[j][r]) & ~0x7Fu) | (unsigned)(127 - (j * 16 + c));
      unsigned kept[4] = {0u, 0u, 0u, 0u};
#pragma unroll 1
      for (int k = 0; k < 16; ++k) {
#pragma unroll
        for (int r = 0; r < 4; ++r) {
          unsigned m = max(max(max(key[0][r], key[1][r]), max(key[2][r], key[3][r])), max(max(key[4][r], key[5][r]), max(key[6][r], key[7][r])));
          m = umax16(m);
          if (c == k) kept[r] = m;
#pragma unroll
          for (int j = 0; j < 8; ++j) key[j][r] = (key[j][r] == m) ? 0u : key[j][r];
        }
      }
#pragma unroll
      for (int r = 0; r < 4; ++r) { sv[pp][r] = funkey(kept[r] & ~0x7Fu); si[pp][r] = 127 - (int)(kept[r] & 0x7Fu); }
    }
    int* EIDX = (int*)(p.ws + OFF_EIDX);
    float* GATE = (float*)(p.ws + OFF_GATE);
    unsigned ck[4][16];
#pragma unroll
    for (int r = 0; r < 4; ++r)
#pragma unroll
      for (int i = 0; i < 16; ++i) {
        const float a = __shfl(sv[0][r], base + i);
        ck[r][i] = ((i + 1) * (c + 1) <= 16) ? ((fkey(a + sv[1][r]) & ~0xFFu) | (unsigned)(255 - (i * 16 + c))) : 0u;
      }
    float tv[4]; int te[4];
#pragma unroll
    for (int r = 0; r < 4; ++r) { tv[r] = 0.f; te[r] = 0; }
#pragma unroll 1
    for (int k = 0; k < 16; ++k) {
#pragma unroll
      for (int r = 0; r < 4; ++r) {
        unsigned m = ck[r][0];
#pragma unroll
        for (int i = 1; i < 16; ++i) m = max(m, ck[r][i]);
        m = umax16(m);
        const int bf = 255 - (int)(m & 0xFFu);
        const int wi = bf >> 4, wj = bf & 15;
        const int e0 = __shfl(si[0][r], base + wi), e1 = __shfl(si[1][r], base + wj);
        if (c == k) { tv[r] = funkey(m & ~0xFFu); te[r] = e0 * 128 + e1; }
#pragma unroll
        for (int i = 0; i < 16; ++i) ck[r][i] = (ck[r][i] == m) ? 0u : ck[r][i];
      }
    }
#pragma unroll
    for (int r = 0; r < 4; ++r) {
      const float mx = __shfl(tv[r], base);
      const float e = __expf(tv[r] - mx);
      const float sum = sum16(e);
      const int tok = m0 + wave * 32 + mt * 16 + quad * 4 + r;
      EIDX[(size_t)tok * 128 + h * 16 + c] = te[r];
      GATE[(size_t)tok * 128 + h * 16 + c] = e / sum;
    }
    }
  }
}

template <bool DRY>
DEV void phaseD4(const Params& p, int li, unsigned char* lds) {
  const int ntok = (li == 0) ? TT : TLAT;
  const int tid_ = opaque_tid(); const int lane = tid_ & 63, wave = tid_ >> 6;
  const unsigned char* PUb = p.ws + OFF_PUB;
  const unsigned char* PVb = PUb + (size_t)16384 * 1024;
  u16* XN = (u16*)(p.ws + OFF_XN);
  for (int item = blockIdx.x; item < ntok / 4; item += gridDim.x) {
    const int tok = item * 4 + wave;
    f32x2 hv2[8];
    {
      const uint4 h0 = *(const uint4*)(XN + (size_t)tok * 1024 + lane * 16), h1 = *(const uint4*)(XN + (size_t)tok * 1024 + lane * 16 + 8);
      float hv[16];
      unpack8(h0, hv); unpack8(h1, hv + 8);
#pragma unroll
      for (int j = 0; j < 8; ++j) hv2[j] = (f32x2){hv[2 * j], hv[2 * j + 1]};
    }
    const int* EI = (const int*)(p.ws + OFF_EIDX) + (size_t)tok * 128;
    const float* GT = (const float*)(p.ws + OFF_GATE) + (size_t)tok * 128;
    const int ei0 = EI[lane], ei1 = EI[64 + lane];
    const float g0 = GT[lane], g1 = GT[64 + lane];
    f32x2 out2[8];
#pragma unroll
    for (int j = 0; j < 8; ++j) out2[j] = (f32x2){0.f, 0.f};
    uint4 ua[8], va[8];
    int e[8]; float gg[8];
#pragma unroll
    for (int u = 0; u < 8; ++u) { e[u] = __shfl(ei0, u); gg[u] = __shfl(g0, u); }
#pragma unroll
    for (int u = 0; u < 8; ++u) { ua[u] = *(const uint4*)(PUb + (size_t)e[u] * 1024 + lane * 16); }
#pragma unroll 1
    for (int i = 0; i < 128; i += 8) {
      float dot[8];
#pragma unroll
      for (int u = 0; u < 8; ++u) { va[u] = *(const uint4*)(PVb + (size_t)e[u] * 1024 + lane * 16); }
#pragma unroll
      for (int u = 0; u < 8; ++u) {
        const unsigned uw[4] = {ua[u].x, ua[u].y, ua[u].z, ua[u].w};
        f32x2 da = (f32x2){0.f, 0.f}, db = da;
#pragma unroll
        for (int q4 = 0; q4 < 4; ++q4) {
          da += __builtin_amdgcn_cvt_pk_f32_fp8((int)uw[q4], false) * hv2[2 * q4];
          db += __builtin_amdgcn_cvt_pk_f32_fp8((int)uw[q4], true) * hv2[2 * q4 + 1];
        }
        da += db;
        dot[u] = (da.x + da.y) * (1.f / PEER_USCALE);
      }
      float gcur[8];
#pragma unroll
      for (int u = 0; u < 8; ++u) gcur[u] = gg[u];
      if (i + 8 < 128) {
#pragma unroll
        for (int u = 0; u < 8; ++u) {
          const int ii = i + 8 + u;
          e[u] = (ii < 64) ? __shfl(ei0, ii) : __shfl(ei1, ii - 64);
          gg[u] = (ii < 64) ? __shfl(g0, ii) : __shfl(g1, ii - 64);
        }
#pragma unroll
        for (int u = 0; u < 8; ++u) { ua[u] = *(const uint4*)(PUb + (size_t)e[u] * 1024 + lane * 16); }
      }
#pragma unroll
      for (int u = 0; u < 8; ++u) dot[u] = wave_sum(dot[u]);
      {
        float mine = dot[0];
#pragma unroll
        for (int u = 1; u < 8; ++u) mine = ((lane & 7) == u) ? dot[u] : mine;
        const float act = 0.5f * mine * (1.f + erff(mine * 0.70710678118654752f));
#pragma unroll
        for (int u = 0; u < 8; ++u) dot[u] = __int_as_float(__builtin_amdgcn_readlane(__float_as_int(act), u)) * gcur[u] * (1.f / PEER_VSCALE);
      }
#pragma unroll
      for (int u = 0; u < 8; ++u) {
        const unsigned vw[4] = {va[u].x, va[u].y, va[u].z, va[u].w};
        const f32x2 a2 = (f32x2){dot[u], dot[u]};
#pragma unroll
        for (int q4 = 0; q4 < 4; ++q4) {
          out2[2 * q4] += a2 * __builtin_amdgcn_cvt_pk_f32_fp8((int)vw[q4], false);
          out2[2 * q4 + 1] += a2 * __builtin_amdgcn_cvt_pk_f32_fp8((int)vw[q4], true);
        }
      }
    }
    float out[16];
#pragma unroll
    for (int j = 0; j < 8; ++j) { out[2 * j] = out2[j].x; out[2 * j + 1] = out2[j].y; }
    const int mv = tok_mv(tok);
    const float* gf = modp(p, li, mv, 5) + lane * 16;
    float* xr = xdst(p, tok) + lane * 16;
    float xv[16]; float ss = 0.f;
#pragma unroll
    for (int j = 0; j < 4; ++j) {
      float4 x = *(const float4*)(xr + j * 4);
      const float4 g = *(const float4*)(gf + j * 4);
      x.x += g.x * out[j * 4]; x.y += g.y * out[j * 4 + 1]; x.z += g.z * out[j * 4 + 2]; x.w += g.w * out[j * 4 + 3];
      if (!DRY) *(float4*)(xr + j * 4) = x;
      xv[j * 4] = x.x; xv[j * 4 + 1] = x.y; xv[j * 4 + 2] = x.z; xv[j * 4 + 3] = x.w;
      ss += x.x * x.x + x.y * x.y + x.z * x.z + x.w * x.w;
    }
    if (DRY) { if (lane == 0) ((float*)(p.ws + OFF_G))[tok] = ss; }
    else if (li == 0) {
      ss = wave_sum(ss);
      const float rstd = rsqrtf(ss * (1.f / 1024.f) + 1e-6f);
      const float* gain = p.in[I_MIXNORM] + 1024 + lane * 16;
      const float* sc = modp(p, 1, mv, 1) + lane * 16;
      const float* sh = modp(p, 1, mv, 0) + lane * 16;
      float o[16];
#pragma unroll
      for (int j = 0; j < 16; ++j) o[j] = xv[j] * rstd * gain[j] * (1.f + sc[j]) + sh[j];
      *(uint4*)(XN + (size_t)tok * 1024 + lane * 16) = pack8(o);
      *(uint4*)(XN + (size_t)tok * 1024 + lane * 16 + 8) = pack8(o + 8);
    }
  }
}

DEV void dump_bf(const Params& p, size_t o0, size_t n0, size_t o1, size_t n1, size_t o2, size_t n2, size_t o3, size_t n3) {
  const size_t Q = 8388608;
  for (size_t i = (size_t)blockIdx.x * 256 + threadIdx.x; i < 4 * Q; i += (size_t)gridDim.x * 256) {
    const int q = (int)(i / Q); const size_t j = i % Q;
    const size_t off = q == 0 ? o0 : q == 1 ? o1 : q == 2 ? o2 : o3;
    const size_t n = q == 0 ? n0 : q == 1 ? n1 : q == 2 ? n2 : n3;
    const size_t stride = (DIAG == 15) ? (n / Q > 2 ? n / Q : 2) : (n / Q > 0 ? n / Q : 1);
    const size_t idx = j * stride;
    p.out[i] = idx < n ? bf2f(((const u16*)(p.ws + off))[idx]) : 0.f;
  }
}
DEV void grid_barrier(const Params& p, int k) {
  asm volatile("s_waitcnt vmcnt(0)" ::: "memory");
  if (k == 0 || (gridDim.x & 7) != 0) {
    cg::this_grid().sync();
  } else {
    __syncthreads();
    if (threadIdx.x == 0) {
      unsigned* bar = (unsigned*)(p.ws + OFF_BAR);
      const unsigned gsz = gridDim.x >> 3, g = blockIdx.x & 7;
      __builtin_amdgcn_fence(__ATOMIC_RELEASE, "agent");
      const unsigned old = __hip_atomic_fetch_add(bar + g * 64, 1u, __ATOMIC_RELAXED, __HIP_MEMORY_SCOPE_AGENT);
      if (old == (unsigned)k * gsz - 1u) __hip_atomic_fetch_add(bar + 8 * 64, 1u, __ATOMIC_RELAXED, __HIP_MEMORY_SCOPE_AGENT);
      while (__hip_atomic_load(bar + 8 * 64, __ATOMIC_RELAXED, __HIP_MEMORY_SCOPE_AGENT) < (unsigned)k * 8u) __builtin_amdgcn_s_sleep(1);
    }
    __syncthreads();
  }
  __builtin_amdgcn_fence(__ATOMIC_ACQUIRE, "agent");
}
#define PH(K, CALL) if (ph_lo <= (K) && (K) < ph_hi) { CALL; if ((K) + 1 < ph_hi) grid_barrier(p, bar_k++); }
__global__ void __launch_bounds__(256, 1) mega(Params p, int ph_lo, int ph_hi) {
  __shared__ __attribute__((aligned(16))) unsigned char lds[LDS_BYTES];
  int bar_k = 0;
#if DIAG == 9
  { uint4* q = (uint4*)(p.ws + OFF_XCTX); const size_t n = (WS_END - OFF_XCTX) / 16;
    for (size_t i = (size_t)blockIdx.x * 256 + threadIdx.x; i < n; i += (size_t)gridDim.x * 256) q[i] = make_uint4(0xAAAAAAAAu, 0xAAAAAAAAu, 0xAAAAAAAAu, 0xAAAAAAAAu);
    cg::this_grid().sync(); }
#endif
  PH(0, phase0a(p, lds))
  PH(1, norm_pass(p, 0, true, p.in[I_MIXNORM], 1, 0, TT))
#if PROBE_AB == 1
  PH(2, (phaseA(p, 0, lds), phaseA(p, 0, lds)))
#else
  PH(2, phaseA(p, 0, lds))
#endif
#if PROBE_AB == 2
  PH(3, (phaseB(p, 0, lds), phaseB(p, 0, lds)))
#else
  PH(3, phaseB(p, 0, lds))
#endif
#if DIAG == 1
  PH(4, dump_bf(p, OFF_QB, 53477376ull, OFF_HYIN, 26738688ull, OFF_G, 26738688ull, OFF_PRW, 49020928ull))
#elif DIAG == 15
  PH(4, dump_bf(p, OFF_HF + 2, 17825790ull, OFF_TW + 2, 16382ull, OFF_H2 + 2, 1114110ull, OFF_ATT, 0ull))
#elif DIAG == 11
  PH(4, dump_bf(p, OFF_PRW + 2 * (49020928ull - 8388608ull), 8388608ull, OFF_PMH + 2 * (41222144ull - 8388608ull), 8388608ull, OFF_QB + 2 * (53477376ull - 8388608ull), 8388608ull, OFF_G + 2 * (26738688ull - 8388608ull), 8388608ull))
#elif DIAG == 2
  PH(4, dump_bf(p, OFF_PRW, 49020928ull, OFF_PMH, 41222144ull, OFF_XN, 35651584ull, OFF_WIN, 5505024ull))
#else
#if PROBE_C
  PH(4, (phaseC(p, 0, lds, 2, PROBE_C), phaseC(p, 0, lds)))
#else
  PH(4, phaseC(p, 0, lds))
#endif
#endif
#if DIAG == 3
  PH(5, dump_bf(p, OFF_ATT, 13369344ull, OFF_HYO, 8912896ull, OFF_Y0, 13369344ull, OFF_Y1, 13369344ull))
#elif DIAG == 12
  PH(5, dump_bf(p, OFF_ATT + 2 * 8388608ull, 4980736ull, OFF_ATT, 0ull, OFF_ATT, 0ull, OFF_ATT, 0ull))
#elif DIAG == 13
  PH(5, dump_bf(p, OFF_Y0 + 2 * 8388608ull, 4980736ull, OFF_Y1 + 2 * 8388608ull, 4980736ull, OFF_ATT, 0ull, OFF_ATT, 0ull))
#elif DIAG == 14
  PH(5, dump_bf(p, OFF_HYO, 8388608ull, OFF_HYO + 2 * 8388608ull, 524288ull, OFF_ATT, 0ull, OFF_ATT, 0ull))
#elif DIAG == 10
  PH(5, dump_bf(p, OFF_ATT + 2 * 4980736ull, 8388608ull, OFF_HYO + 2 * 524288ull, 8388608ull, OFF_Y0 + 2 * 4980736ull, 8388608ull, OFF_Y1 + 2 * 4980736ull, 8388608ull))
#else
#if PROBE_AB == 3
  PH(5, (phaseD1(p, 0, lds), phaseD1(p, 0, lds)))
#else
  PH(5, (phaseD0(p, 0), grid_barrier(p, bar_k++), phaseD1(p, 0, lds)))
#endif
#endif
  PH(6, (norm_pass(p, 0, false, p.in[I_FFNNORM], 4, 3, TT), cvt_peer(p, 0)))
#if PROBE_D3
  PH(7, (phaseD3(p, 0, lds), phaseD3(p, 0, lds)))
#else
  PH(7, phaseD3(p, 0, lds))
#endif
#if PROBE_D4
  PH(8, (phaseD4<true>(p, 0, lds), phaseD4<false>(p, 0, lds)))
#else
  PH(8, phaseD4<false>(p, 0, lds))
#endif
  PH(9, phaseA(p, 1, lds))
  PH(10, phaseB(p, 1, lds))
  PH(11, phaseC(p, 1, lds))
  PH(12, (phaseD0(p, 1), grid_barrier(p, bar_k++), phaseD1(p, 1, lds)))
  PH(13, (norm_pass(p, 1, false, p.in[I_FFNNORM] + 1024, 4, 3, TLAT), cvt_peer(p, 1)))
  PH(14, phaseD3(p, 1, lds))
  PH(15, phaseD4<false>(p, 1, lds))
}

extern "C" void kernel_launch(void* const* d_in, const int* in_sizes, int n_in, void* d_out, int out_size, void* d_ws, size_t ws_size, hipStream_t stream) {
  static int grid_blocks = 0;
  if (!grid_blocks) {
    int dev = 0, cus = 0, per_cu = 0;
    hipGetDevice(&dev);
    hipDeviceGetAttribute(&cus, hipDeviceAttributeMultiprocessorCount, dev);
    hipOccupancyMaxActiveBlocksPerMultiprocessor(&per_cu, mega, 256, 0);
    if (per_cu > GRID_BLOCKS_PER_CU) per_cu = GRID_BLOCKS_PER_CU;
    if (per_cu < 1) per_cu = 1;
    grid_blocks = cus * per_cu;
  }
  if (n_in != N_IN || ws_size < WS_NEED) { fprintf(stderr, "kernel_launch: bad inputs n_in=%d ws=%zu need %zu\n", n_in, ws_size, (size_t)WS_NEED); return; }
  Params p{};
  for (int i = 0; i < N_IN; ++i) p.in[i] = (const float*)d_in[i];
  p.out = (float*)d_out; p.ws = (unsigned char*)d_ws;
#if MULTI_LAUNCH
  for (int ph = 0; ph < NPH; ++ph) hipLaunchKernelGGL(mega, dim3(grid_blocks), dim3(256), 0, stream, p, ph, ph + 1);
#else
  int lo = 0, hi = NPH;
  void* args[] = {&p, &lo, &hi};
  hipError_t e = hipLaunchCooperativeKernel((void*)mega, dim3(grid_blocks), dim3(256), args, 0, stream);
  if (e != hipSuccess) fprintf(stderr, "cooperative launch failed: %s (grid %d)\n", hipGetErrorString(e), grid_blocks);
#endif
}
```
